# Optimizing an MI355X kernel written in HIP

```python
import jax, jax.numpy as jnp
from jax import lax
import numpy as np

D_MODEL = 1024
BATCH = 8
SEQ = 8192
DEPTH = 2
DEC_BATCH = 8
DEC_SEQ = 32
PAST_LEN = 4096

CHUNK = 64
N_RET_HEADS = 4
RET_HEAD_DIM = 128
RET_DIM = N_RET_HEADS * RET_HEAD_DIM
CONV_DIM = D_MODEL - RET_DIM
CONV_WIDTH = 3
MIX_DIM = RET_DIM + CONV_DIM
IN_DIM = 4 * RET_DIM + 3 * CONV_DIM
D_FF = 2816
N_MOD = 9
ROPE_BASE = 10000.0
EPS = 1e-6

kernel_name = "hybrid_retention_shortconv_macaron_stream"


def rmsnorm(x, g):
    x32 = x.astype(jnp.float32)
    y = x32 * lax.rsqrt(jnp.mean(x32 * x32, axis=-1, keepdims=True) + EPS)
    return (y * g.astype(jnp.float32)).astype(x.dtype)


def modulate(h, shift, scale):
    return h * (1 + scale[:, None, :]) + shift[:, None, :]


def swiglu(h, w_in, w_out):
    gate, up = jnp.split(h @ w_in, 2, axis=-1)
    return (jax.nn.silu(gate) * up) @ w_out


def rotary(x, pos):
    half = x.shape[-1] // 2
    inv = ROPE_BASE ** (-jnp.arange(half, dtype=jnp.float32) / half)
    ang = pos.astype(jnp.float32)[:, None] * inv[None, :]
    cos = jnp.cos(ang)[None, :, None, :]
    sin = jnp.sin(ang)[None, :, None, :]
    x32 = x.astype(jnp.float32)
    x1, x2 = x32[..., :half], x32[..., half:]
    return jnp.concatenate([x1 * cos - x2 * sin, x1 * sin + x2 * cos], axis=-1).astype(x.dtype)


def retention_log_gamma():
    return jnp.log1p(-jnp.exp2(-5.0 - jnp.arange(N_RET_HEADS, dtype=jnp.float32)))


def retention_chunk(q, k, v, S, log_gamma):
    L = q.shape[1]
    idx = jnp.arange(L, dtype=jnp.float32)
    dist = jnp.abs(idx[:, None] - idx[None, :])
    decay = jnp.exp(log_gamma[:, None, None] * dist)
    scores = jnp.einsum('bihd,bjhd->bhij', q, k) * decay[None]
    intra = jnp.einsum('bhij,bjhe->bihe', scores, v)
    cross_decay = jnp.exp(log_gamma[:, None] * (idx[None, :] + 1.0))
    cross = jnp.einsum('bihd,bhde->bihe', q, S) * jnp.transpose(cross_decay)[None, :, :, None]
    kdec = jnp.exp(log_gamma[:, None] * (L - 1.0 - idx[None, :]))
    S_new = jnp.exp(log_gamma * L)[None, :, None, None] * S + jnp.einsum('bjhd,hj,bjhe->bhde', k, kdec, v)
    return intra + cross, S_new


def retention_prompt(q, k, v, log_gamma):
    B, L, H, Dk = q.shape
    Dv = v.shape[-1]
    nc = L // CHUNK

    def to_chunks(t):
        return jnp.moveaxis(t.reshape(B, nc, CHUNK, H, t.shape[-1]), 1, 0)

    def step(S, qkv):
        qc, kc, vc = qkv
        o, S = retention_chunk(qc, kc, vc, S, log_gamma)
        return S, o

    S0 = jnp.zeros((B, H, Dk, Dv), jnp.float32)
    S_fin, o = lax.scan(step, S0, (to_chunks(q), to_chunks(k), to_chunks(v)))
    o = jnp.moveaxis(o, 0, 1).reshape(B, L, H, Dv)
    return o, S_fin


def short_conv(u, hist, w, b):
    L = u.shape[1]
    ext = jnp.concatenate([hist.astype(u.dtype), u], axis=1)
    y = b + sum(ext[:, j:j + L] * w[j] for j in range(CONV_WIDTH))
    return y, ext[:, -(CONV_WIDTH - 1):]


def mixer(h, pos, S, hist, chunked, w_in, w_out, gn_g, conv_w, conv_b):
    B, L, _ = h.shape
    p = h @ w_in
    q, k, v, g, bg, cg, hin = jnp.split(
        p, [RET_DIM, 2 * RET_DIM, 3 * RET_DIM, 4 * RET_DIM, 4 * RET_DIM + CONV_DIM, 4 * RET_DIM + 2 * CONV_DIM], axis=-1)
    q = rotary(q.reshape(B, L, N_RET_HEADS, RET_HEAD_DIM), pos)
    k = rotary(k.reshape(B, L, N_RET_HEADS, RET_HEAD_DIM), pos) * (RET_HEAD_DIM ** -0.5)
    v = v.reshape(B, L, N_RET_HEADS, RET_HEAD_DIM)
    log_gamma = retention_log_gamma()
    if chunked:
        o, S_new = retention_prompt(q, k, v, log_gamma)
    else:
        o, S_new = retention_chunk(q, k, v, S, log_gamma)
    o32 = o.astype(jnp.float32)
    mu = jnp.mean(o32, axis=-1, keepdims=True)
    var = jnp.mean(jnp.square(o32 - mu), axis=-1, keepdims=True)
    o_n = ((o32 - mu) * lax.rsqrt(var + EPS)).reshape(B, L, RET_DIM) * gn_g.astype(jnp.float32)
    ret_out = (jax.nn.silu(g.astype(jnp.float32)) * o_n).astype(h.dtype)
    y, hist_new = short_conv(cg * hin, hist, conv_w, conv_b)
    conv_out = (bg * y).astype(h.dtype)
    out = jnp.concatenate([ret_out, conv_out], axis=-1) @ w_out
    return out, S_new, hist_new


def run_trunk(x, c, pos, S_all, hist_all, chunked, w_ada, b_ada, g_ffn1, w_ffn1_in, w_ffn1_out,
              g_mix, w_in, gn_g, conv_w, conv_b, w_out, g_ffn2, w_ffn2_in, w_ffn2_out, g_final):
    B = x.shape[0]
    S_list, hist_list = [], []
    for l in range(DEPTH):
        mod = (jax.nn.silu(c) @ w_ada[l] + b_ada[l]).reshape(B, N_MOD, D_MODEL)
        sh1, sc1, gt1, shm, scm, gtm, sh2, sc2, gt2 = [mod[:, i] for i in range(N_MOD)]
        h = modulate(rmsnorm(x, g_ffn1[l]), sh1, sc1)
        x = x + 0.5 * gt1[:, None, :] * swiglu(h, w_ffn1_in[l], w_ffn1_out[l])
        h = modulate(rmsnorm(x, g_mix[l]), shm, scm)
        S_l = None if chunked else S_all[l]
        hist_l = jnp.zeros((B, CONV_WIDTH - 1, CONV_DIM), x.dtype) if chunked else hist_all[l]
        m, S_new, hist_new = mixer(h, pos, S_l, hist_l, chunked, w_in[l], w_out[l], gn_g[l], conv_w[l], conv_b[l])
        x = x + gtm[:, None, :] * m
        h = modulate(rmsnorm(x, g_ffn2[l]), sh2, sc2)
        x = x + 0.5 * gt2[:, None, :] * swiglu(h, w_ffn2_in[l], w_ffn2_out[l])
        S_list.append(S_new.astype(x.dtype))
        hist_list.append(hist_new.astype(x.dtype))
    return rmsnorm(x, g_final), jnp.stack(S_list), jnp.stack(hist_list)


def setup_inputs(seed: int = 0) -> dict:
    key = jax.random.key(seed)
    ks = jax.random.split(key, 24)
    f32 = jnp.float32
    nrm = lambda k, shape, s: jax.random.normal(k, shape, f32) * s
    return {
        "x_prompt": nrm(ks[0], (BATCH, SEQ, D_MODEL), 1.0),
        "x_sample": nrm(ks[1], (DEC_BATCH, DEC_SEQ, D_MODEL), 1.0),
        "c_prompt": nrm(ks[2], (BATCH, D_MODEL), 1.0),
        "c_sample": nrm(ks[3], (DEC_BATCH, D_MODEL), 1.0),
        "state_ret": nrm(ks[4], (DEPTH, DEC_BATCH, N_RET_HEADS, RET_HEAD_DIM, RET_HEAD_DIM), 0.5),
        "state_conv": nrm(ks[5], (DEPTH, DEC_BATCH, CONV_WIDTH - 1, CONV_DIM), 1.0),
        "w_ada": nrm(ks[6], (DEPTH, D_MODEL, N_MOD * D_MODEL), 0.5 * D_MODEL ** -0.5),
        "b_ada": nrm(ks[7], (DEPTH, N_MOD * D_MODEL), 0.02),
        "g_ffn1": 1.0 + nrm(ks[8], (DEPTH, D_MODEL), 0.1),
        "w_ffn1_in": nrm(ks[9], (DEPTH, D_MODEL, 2 * D_FF), D_MODEL ** -0.5),
        "w_ffn1_out": nrm(ks[10], (DEPTH, D_FF, D_MODEL), D_FF ** -0.5),
        "g_mix": 1.0 + nrm(ks[11], (DEPTH, D_MODEL), 0.1),
        "w_in": nrm(ks[12], (DEPTH, D_MODEL, IN_DIM), D_MODEL ** -0.5),
        "gn_g": 1.0 + nrm(ks[13], (DEPTH, RET_DIM), 0.1),
        "conv_w": nrm(ks[14], (DEPTH, CONV_WIDTH, CONV_DIM), CONV_WIDTH ** -0.5),
        "conv_b": nrm(ks[15], (DEPTH, CONV_DIM), 0.01),
        "w_out": nrm(ks[16], (DEPTH, MIX_DIM, D_MODEL), MIX_DIM ** -0.5),
        "g_ffn2": 1.0 + nrm(ks[17], (DEPTH, D_MODEL), 0.1),
        "w_ffn2_in": nrm(ks[18], (DEPTH, D_MODEL, 2 * D_FF), D_MODEL ** -0.5),
        "w_ffn2_out": nrm(ks[19], (DEPTH, D_FF, D_MODEL), D_FF ** -0.5),
        "g_final": 1.0 + nrm(ks[20], (D_MODEL,), 0.1),
    }


def reference(x_prompt, x_sample, c_prompt, c_sample, state_ret, state_conv, w_ada, b_ada, g_ffn1,
              w_ffn1_in, w_ffn1_out, g_mix, w_in, gn_g, conv_w, conv_b, w_out, g_ffn2, w_ffn2_in,
              w_ffn2_out, g_final):
    pos_prompt = jnp.arange(x_prompt.shape[1])
    pos_sample = PAST_LEN + jnp.arange(x_sample.shape[1])
    y_prompt, state_ret_prompt, state_conv_prompt = run_trunk(
        x_prompt, c_prompt, pos_prompt, None, None, True, w_ada, b_ada, g_ffn1, w_ffn1_in, w_ffn1_out,
        g_mix, w_in, gn_g, conv_w, conv_b, w_out, g_ffn2, w_ffn2_in, w_ffn2_out, g_final)
    y_sample, state_ret_sample, state_conv_sample = run_trunk(
        x_sample, c_sample, pos_sample, state_ret, state_conv, False, w_ada, b_ada, g_ffn1, w_ffn1_in, w_ffn1_out,
        g_mix, w_in, gn_g, conv_w, conv_b, w_out, g_ffn2, w_ffn2_in, w_ffn2_out, g_final)
    return (y_prompt, y_sample, state_ret_prompt, state_conv_prompt, state_ret_sample, state_conv_sample)
```

```cpp
#include <hip/hip_runtime.h>
#include <hip/hip_cooperative_groups.h>
#include <cstdio>
#include <cstdint>
namespace cg = cooperative_groups;
#define MK_SINGLE 0
namespace pg8 {
#define PG8_LAS __attribute__((address_space(3)))
typedef unsigned short bf16_t;
typedef short bf16x8 __attribute__((ext_vector_type(8)));
typedef float f32x4 __attribute__((ext_vector_type(4)));
typedef unsigned u32x4 __attribute__((ext_vector_type(4)));
constexpr int BM = 256, BK = 64, HALF = 128, HTB = HALF * BK * 2  , STAGE_BYTES = 8 * HTB, NXCD = 8, WGM = 8;

__host__ __device__ __forceinline__ int lds_byte(int r, int c) { const int st = (r >> 4) * 2 + (c >> 5), rr = r & 15, cc = c & 31, ob = rr * 64 + cc * 2; return st * 1024 + (ob ^ (((ob >> 9) & 1) << 5)); }
__host__ __device__ __forceinline__ void stage_rc(int b, int& R, int& C) { const int st = b / 1024, sb = b % 1024, swz = sb ^ (((sb >> 9) & 1) << 5); R = (st >> 1) * 16 + swz / 64; C = (st & 1) * 32 + (swz % 64) / 2; }
__host__ __device__ __forceinline__ int perm32(int rho) { const int n = rho >> 4, i = rho & 15; return 8 * (i >> 2) + 4 * n + (i & 3); }

struct Unit { int pm, pn; };
struct Gemm { const bf16_t* A; const bf16_t* Bt; int M, N, K; };

struct StaticOrder {
    int nM, nN, nwg, G, c;
    __host__ __device__ void init(int M, int N, int G_, int c_) { nM = M / BM; nN = N / BM; nwg = nM * nN; G = G_; c = c_; }
    __host__ __device__ bool next(int i, Unit& u) const {
        const long L = (long)i * G + c; if (L >= nwg) return false;
        int wgid = (int)L; { const int q = nwg / NXCD, r = nwg % NXCD, xcd = wgid % NXCD, off = wgid / NXCD; wgid = (xcd < r ? xcd * (q + 1) : r * (q + 1) + (xcd - r) * q) + off; }
        const int nig = WGM * nN, gid = wgid / nig, fm = gid * WGM, gsz = (nM - fm) < WGM ? (nM - fm) : WGM;
        u.pm = fm + ((wgid % nig) % gsz); u.pn = (wgid % nig) / gsz; return true;
    }
    __device__ __forceinline__ void a_ready(const Unit&) const {}
    __device__ __forceinline__ void done(const Unit&) const {}
};
__device__ __forceinline__ unsigned cvt_pk_bf16(float lo, float hi) { unsigned r; asm volatile("v_cvt_pk_bf16_f32 %0, %1, %2" : "=v"(r) : "v"(lo), "v"(hi)); return r; }
template <class Epi, class Sched, bool ALIGN_EPI = false, bool SP2 = false>
__device__ __forceinline__ void gemm_phase(PG8_LAS unsigned char* lds, const Gemm g, const Sched& S, const Epi& E) {
    int tid_l = threadIdx.x; asm volatile("" : "+v"(tid_l));
    const int tid = tid_l, wid = __builtin_amdgcn_readfirstlane(tid >> 6), lane = tid & 63, wr = wid >> 2, wc = wid & 3, fr = lane & 15, fq = lane >> 4;
    const int K = g.K, nt = K / BK;
    unsigned voffA[2], voffB[2];
#pragma unroll
    for (int i = 0; i < 2; ++i) { int R, C; stage_rc(tid * 16 + i * 8192, R, C); const int Rb = Epi::PERM ? ((R & ~31) + perm32(R & 31)) : R;
        voffA[i] = (unsigned)(R * K + C) * 2u; voffB[i] = (unsigned)(Rb * K + C) * 2u; }
    const size_t kstep = (size_t)(BK * 2);
    const size_t hstep = (size_t)HALF * K * 2;
    const size_t tstep = 2 * hstep;
    const unsigned ldsw = (unsigned)wid * 1024u;
    const int aoff = lds_byte(wr * 64 + fr, fq * 8), boff = lds_byte(wc * 32 + fr, fq * 8);
#define PG8_SA(b, h) (((b) * 2 + (h)) * HTB)
#define PG8_SB(b, h) ((4 + (b) * 2 + (h)) * HTB)
#define PG8_STAGE(bufoff, gbase, voff) do { _Pragma("unroll") for (int _i = 0; _i < 2; ++_i) \
        __builtin_amdgcn_global_load_lds((const unsigned*)((const char*)(gbase) + (voff)[_i]), (PG8_LAS unsigned*)(lds + (bufoff) + ldsw + _i * 8192), 16, 0, 0); } while (0)
#define PG8_LDA(dst, b, h) do { _Pragma("unroll") for (int m = 0; m < 4; ++m) _Pragma("unroll") for (int k = 0; k < 2; ++k) dst[m][k] = *(const PG8_LAS bf16x8*)(lds + PG8_SA(b, h) + aoff + m * 2048 + k * 1024); } while (0)
#define PG8_LDB(dst, b, h) do { _Pragma("unroll") for (int n = 0; n < 2; ++n) _Pragma("unroll") for (int k = 0; k < 2; ++k) dst[n][k] = *(const PG8_LAS bf16x8*)(lds + PG8_SB(b, h) + boff + n * 2048 + k * 1024); } while (0)
#define PG8_MMA(ai, bj, At, Bt) do { __builtin_amdgcn_s_setprio(1); _Pragma("unroll") for (int m = 0; m < 4; ++m) _Pragma("unroll") for (int n = 0; n < 2; ++n) _Pragma("unroll") for (int k = 0; k < 2; ++k) \
        acc[ai][bj][m][n] = __builtin_amdgcn_mfma_f32_16x16x32_bf16(Bt[n][k], At[m][k], acc[ai][bj][m][n], 0, 0, 0); __builtin_amdgcn_s_setprio(0); } while (0)
#define PG8_WAIT_V(n) asm volatile("s_waitcnt vmcnt(" #n ")" ::: "memory")
#define PG8_WAIT_L(n) asm volatile("s_waitcnt lgkmcnt(" #n ")" ::: "memory")
#define PG8_BAR __builtin_amdgcn_s_barrier()
#define PG8_SCHED __builtin_amdgcn_sched_barrier(0)
    Unit cur, nxt; int ui = 0;
    if (!S.next(0, cur)) return;
    f32x4 acc[2][2][4][2];
#pragma unroll
    for (int a = 0; a < 2; ++a)
#pragma unroll
        for (int b = 0; b < 2; ++b)
#pragma unroll
            for (int m = 0; m < 4; ++m)
#pragma unroll
                for (int n = 0; n < 2; ++n) acc[a][b][m][n] = (f32x4){0.f, 0.f, 0.f, 0.f};
    bf16x8 At[4][2], B0[2][2], B1[2][2];
    const char* cA = (const char*)g.A + (size_t)cur.pm * tstep; const char* cB = (const char*)g.Bt + (size_t)cur.pn * tstep;
    S.a_ready(cur);
    if constexpr (SP2) {
        PG8_STAGE(PG8_SB(0, 0), cB, voffB); PG8_STAGE(PG8_SB(0, 1), cB + hstep, voffB); PG8_STAGE(PG8_SA(0, 0), cA, voffA); PG8_STAGE(PG8_SA(0, 1), cA + hstep, voffA);
        if (wr == 1) PG8_BAR;
        PG8_WAIT_V(2); PG8_BAR;
        PG8_STAGE(PG8_SB(1, 0), cB + kstep, voffB); PG8_STAGE(PG8_SA(1, 0), cA + kstep, voffA); PG8_STAGE(PG8_SB(1, 1), cB + hstep + kstep, voffB);
        PG8_WAIT_V(6); PG8_BAR;
    } else {
        PG8_STAGE(PG8_SB(0, 0), cB, voffB); PG8_STAGE(PG8_SA(0, 0), cA, voffA); PG8_STAGE(PG8_SB(0, 1), cB + hstep, voffB); PG8_STAGE(PG8_SA(0, 1), cA + hstep, voffA);
        if (wr == 1) PG8_BAR;
        PG8_WAIT_V(4); PG8_BAR;
        PG8_STAGE(PG8_SB(1, 0), cB + kstep, voffB); PG8_STAGE(PG8_SA(1, 0), cA + kstep, voffA); PG8_STAGE(PG8_SB(1, 1), cB + hstep + kstep, voffB);
        PG8_WAIT_V(6); PG8_BAR;
    }
    for (;;) {
        const bool has_next = S.next(ui + 1, nxt);
        const char* nA = has_next ? (const char*)g.A + (size_t)nxt.pm * tstep : cA; const char* nB = has_next ? (const char*)g.Bt + (size_t)nxt.pn * tstep : cB;
        for (int t = 0; t < nt; t += 2) {
            const bool last = (t == nt - 2);
            const char* a1 = cA + (size_t)(t + 1) * kstep;
            const char* a2 = last ? nA : cA + (size_t)(t + 2) * kstep; const char* b2 = last ? nB : cB + (size_t)(t + 2) * kstep;
            const char* a3 = a2 + kstep; const char* b3 = b2 + kstep;
            if (last && has_next) S.a_ready(nxt);
            if constexpr (SP2) {
            PG8_LDB(B0, 0, 0); PG8_LDB(B1, 0, 1); PG8_SCHED; PG8_LDA(At, 0, 0); PG8_STAGE(PG8_SA(1, 1), a1 + hstep, voffA);
            PG8_WAIT_V(8); PG8_WAIT_L(0); PG8_BAR; PG8_MMA(0, 0, At, B0); PG8_MMA(0, 1, At, B1); PG8_BAR; PG8_SCHED;
            PG8_LDA(At, 0, 1); PG8_STAGE(PG8_SB(0, 0), b2, voffB); PG8_STAGE(PG8_SB(0, 1), b2 + hstep, voffB); PG8_STAGE(PG8_SA(0, 0), a2, voffA);
            PG8_WAIT_V(8); PG8_WAIT_L(0); PG8_BAR; PG8_MMA(1, 0, At, B0); PG8_MMA(1, 1, At, B1); PG8_BAR; PG8_SCHED;
            PG8_LDB(B0, 1, 0); PG8_LDB(B1, 1, 1); PG8_SCHED; PG8_LDA(At, 1, 0); PG8_STAGE(PG8_SA(0, 1), a2 + hstep, voffA);
            PG8_WAIT_V(8); PG8_WAIT_L(0); PG8_BAR; PG8_MMA(0, 0, At, B0); PG8_MMA(0, 1, At, B1); PG8_BAR; PG8_SCHED;
            PG8_LDA(At, 1, 1); PG8_STAGE(PG8_SB(1, 0), b3, voffB); PG8_STAGE(PG8_SB(1, 1), b3 + hstep, voffB); PG8_STAGE(PG8_SA(1, 0), a3, voffA);
            PG8_WAIT_V(8); PG8_WAIT_L(0); PG8_BAR; PG8_MMA(1, 0, At, B0); PG8_MMA(1, 1, At, B1); PG8_BAR; PG8_SCHED;
            } else {
            PG8_LDB(B0, 0, 0); PG8_SCHED; PG8_LDA(At, 0, 0); PG8_STAGE(PG8_SA(1, 1), a1 + hstep, voffA);
            PG8_WAIT_L(8); PG8_BAR; PG8_WAIT_L(0); PG8_MMA(0, 0, At, B0); PG8_BAR; PG8_SCHED;
            PG8_LDB(B1, 0, 1); PG8_STAGE(PG8_SB(0, 0), b2, voffB);
            PG8_BAR; PG8_WAIT_L(0); PG8_MMA(0, 1, At, B1); PG8_BAR;
            PG8_LDA(At, 0, 1); PG8_STAGE(PG8_SA(0, 0), a2, voffA);
            PG8_BAR; PG8_WAIT_L(0); PG8_MMA(1, 0, At, B0); PG8_BAR; PG8_SCHED;
            PG8_STAGE(PG8_SB(0, 1), b2 + hstep, voffB);
            PG8_WAIT_V(6); PG8_BAR; PG8_MMA(1, 1, At, B1); PG8_BAR;
            PG8_LDB(B0, 1, 0); PG8_SCHED; PG8_LDA(At, 1, 0); PG8_STAGE(PG8_SA(0, 1), a2 + hstep, voffA);
            PG8_WAIT_L(8); PG8_BAR; PG8_WAIT_L(0); PG8_MMA(0, 0, At, B0); PG8_BAR; PG8_SCHED;
            PG8_LDB(B1, 1, 1); PG8_STAGE(PG8_SB(1, 0), b3, voffB);
            PG8_BAR; PG8_WAIT_L(0); PG8_MMA(0, 1, At, B1); PG8_BAR;
            PG8_LDA(At, 1, 1); PG8_STAGE(PG8_SA(1, 0), a3, voffA);
            PG8_BAR; PG8_WAIT_L(0); PG8_MMA(1, 0, At, B0); PG8_BAR; PG8_SCHED;
            PG8_STAGE(PG8_SB(1, 1), b3 + hstep, voffB);
            PG8_WAIT_V(6); PG8_BAR; PG8_MMA(1, 1, At, B1); PG8_BAR;
            }
        }
        if constexpr (ALIGN_EPI) { if (wr == 0) PG8_BAR; }
        if constexpr (!Epi::AFTER_DRAIN) { E(acc, cur, wr, wc, fr, fq); S.done(cur); }
        if (!has_next) break;
#pragma unroll
        for (int a = 0; a < 2; ++a)
#pragma unroll
            for (int b = 0; b < 2; ++b)
#pragma unroll
                for (int m = 0; m < 4; ++m)
#pragma unroll
                    for (int n = 0; n < 2; ++n) acc[a][b][m][n] = (f32x4){0.f, 0.f, 0.f, 0.f};
        cur = nxt; cA = nA; cB = nB; ++ui;
        if constexpr (ALIGN_EPI) { if (wr == 1) PG8_BAR; }
    }
    PG8_WAIT_V(0);
    if constexpr (!ALIGN_EPI) { if (wr == 0) PG8_BAR; }
    PG8_BAR;
    if constexpr (Epi::AFTER_DRAIN) { E.fused(acc, cur, wr, wc, fr, fq, lds, wid, lane); S.done(cur); }
#undef PG8_SA
#undef PG8_SB
#undef PG8_STAGE
#undef PG8_LDA
#undef PG8_LDB
#undef PG8_MMA
#undef PG8_WAIT_V
#undef PG8_WAIT_L
#undef PG8_BAR
#undef PG8_SCHED
}
}
#define GAS __attribute__((address_space(1)))
#define LAS __attribute__((address_space(3)))
typedef unsigned short bf16;
typedef unsigned v4u __attribute__((ext_vector_type(4)));
typedef float f32x4 __attribute__((ext_vector_type(4)));
typedef short bf16x8 __attribute__((ext_vector_type(8)));
typedef GAS unsigned gu32;
typedef GAS unsigned long long gu64;
#define RLX_AGENT __ATOMIC_RELAXED, __HIP_MEMORY_SCOPE_AGENT
#define LDS_WAIT() asm volatile("s_waitcnt lgkmcnt(0)" ::: "memory")
#define VM_WAIT() asm volatile("s_waitcnt vmcnt(0)" ::: "memory")
__device__ __forceinline__ unsigned long long rt() { return __builtin_amdgcn_s_memrealtime(); }
__device__ __forceinline__ unsigned f2bf(float f) { unsigned u = __builtin_bit_cast(unsigned, f); return (u + 0x7fffu + ((u >> 16) & 1u)) >> 16; }
__device__ __forceinline__ unsigned pk2(float lo, float hi) { return f2bf(lo) | (f2bf(hi) << 16); }

#define XB_TMO      128
#define XB_XCNT(j)  (256  + 64 * (j))
#define XB_XSUB(j)  (1280 + 64 * (j))
#define XB_XGEN(j)  (2304 + 64 * (j))
#define XB_TOP      3328
#define XB_TOPGEN   3392
#define XCD_BAR_WORDS 3456
#define XB_SPIN_CAP (1u << 18)

__device__ __forceinline__ unsigned xb_ld(unsigned* p)              { return __hip_atomic_load(p, __ATOMIC_RELAXED, __HIP_MEMORY_SCOPE_AGENT); }
__device__ __forceinline__ unsigned xb_add(unsigned* p, unsigned v) { return __hip_atomic_fetch_add(p, v, __ATOMIC_RELAXED, __HIP_MEMORY_SCOPE_AGENT); }
__device__ __forceinline__ unsigned xb_xcc_id() { return (unsigned)__builtin_amdgcn_s_getreg((3 << 11) | 20) & 0xFu; }
#define XB_SPIN(cond, bar) do { unsigned _sp = 0; while (cond) { __builtin_amdgcn_s_sleep(1); \
    if ((++_sp & 255u) == 0u) { if (xb_ld(&(bar)[XB_TMO])) break; if (_sp > XB_SPIN_CAP) { atomicAdd(&(bar)[XB_TMO], 1u); break; } } } } while (0)

struct XcdBarrier {
    unsigned* bar; unsigned x;
    volatile LAS unsigned* st;
};

__device__ __forceinline__ XcdBarrier xcd_barrier_post(unsigned* bar, volatile LAS unsigned* st) {
    XcdBarrier b; b.bar = bar; b.x = xb_xcc_id(); b.st = st;
    if (threadIdx.x == 0) (void)xb_add(&bar[XB_XCNT(b.x)], 1u);
    return b;
}
__device__ __forceinline__ void xcd_barrier_complete(unsigned* bar, unsigned x, unsigned& nloc, unsigned& nx) {
    const unsigned G = gridDim.x * gridDim.y * gridDim.z;
    unsigned sum, cnt, mine, sp = 0u;
    for (;;) {
        sum = 0u; cnt = 0u; mine = 0u;
#pragma unroll
        for (unsigned j = 0; j < 16; ++j) { const unsigned c = xb_ld(&bar[XB_XCNT(j)]); sum += c; cnt += (c > 0u) ? 1u : 0u; mine = (j == x) ? c : mine; }
        if (sum == G) break;
        __builtin_amdgcn_s_sleep(1);
        if ((++sp & 255u) == 0u) { if (xb_ld(&bar[XB_TMO])) break; if (sp > XB_SPIN_CAP) { atomicAdd(&bar[XB_TMO], 1u); break; } }
    }
    nloc = mine > 0u ? mine : 1u; nx = cnt > 0u ? cnt : 1u;
}

__device__ __forceinline__ void xcd_barrier(const XcdBarrier& b) {
    asm volatile("s_waitcnt vmcnt(0)" ::: "memory");
    __syncthreads();
    if (threadIdx.x == 0) {
        unsigned* bar = b.bar;
        __builtin_amdgcn_s_waitcnt(0);
        unsigned nloc = b.st[0], nx = b.st[1];
        if (nloc == 0u) { xcd_barrier_complete(bar, b.x, nloc, nx); b.st[0] = nloc; b.st[1] = nx; }
        const unsigned old = xb_add(&bar[XB_XSUB(b.x)], 1u);
        const unsigned gen = old / nloc;
        if (old + 1u == (gen + 1u) * nloc) {
            __builtin_amdgcn_fence(__ATOMIC_RELEASE, "agent");
            asm volatile("s_waitcnt vmcnt(0)" ::: "memory");
            const unsigned og = xb_add(&bar[XB_TOP], 1u);
            const unsigned tg = og / nx;
            if (og + 1u == (tg + 1u) * nx) xb_add(&bar[XB_TOPGEN], 1u);
            else XB_SPIN(xb_ld(&bar[XB_TOPGEN]) == tg, bar);
            __builtin_amdgcn_fence(__ATOMIC_ACQUIRE, "agent");
            xb_add(&bar[XB_XGEN(b.x)], 1u);
            asm volatile("s_waitcnt vmcnt(0)" ::: "memory");
        } else {
            XB_SPIN(xb_ld(&bar[XB_XGEN(b.x)]) == gen, bar);
            __builtin_amdgcn_fence(__ATOMIC_ACQUIRE, "agent");
            asm volatile("s_waitcnt vmcnt(0)" ::: "memory");
        }
    }
    __syncthreads();
}

constexpr int NWAVES = 8;
constexpr int D = 1024, DFF = 2816, NFI = 2 * DFF, NIN = 3584, NMOD = 9, MODW = NMOD * D;
constexpr int NB_P = 8, SEQ = 8192, NB_S = 8, DSEQ = 32, PAST = 4096, DEPTH = 2;
constexpr int MP = NB_P * SEQ, MS = NB_S * DSEQ, MT = MP + MS;
constexpr int NHEAD = 4, HD = 128, RET = 512, CONVD = 512;
constexpr float EPS = 1e-6f;
constexpr size_t OFF_Y = 0, OFF_SRP = (size_t)MT * D, SZ_SR = (size_t)DEPTH * 8 * NHEAD * HD * HD, OFF_SCP = OFF_SRP + SZ_SR, SZ_SC = (size_t)DEPTH * 8 * 2 * CONVD,
                 OFF_SRS = OFF_SCP + SZ_SC, OFF_SCS = OFF_SRS + SZ_SR;
constexpr size_t MiB = 1u << 20;
constexpr size_t WS_CTL = 0, CTL_ZERO_BYTES = 1 * MiB;
constexpr size_t WS_MOD = 1 * MiB;
constexpr size_t WS_ROPE = 3 * MiB;
constexpr size_t WS_W = 8 * MiB;
constexpr size_t W_1I = 0, W_1O = 11 * MiB, W_IN = 17 * MiB, W_OUT = 24 * MiB, W_2I = 26 * MiB, W_2O = 37 * MiB, W_LAYER = 43 * MiB;
constexpr size_t WS_T = 96 * MiB;
constexpr size_t WS_H = 128 * MiB;
constexpr size_t WS_BIG = 260 * MiB;
constexpr size_t SZ_M512 = (size_t)MT * 512 * 2;
constexpr size_t WS_END = WS_BIG + 6 * SZ_M512;
static_assert((size_t)MT * DFF * 2 <= 6 * SZ_M512, "overlay");
constexpr int CW_BAR = 4096;
constexpr int RING_BYTES = 131072, LDSCTL_OFF = RING_BYTES, MISC_OFF = LDSCTL_OFF + 320, LDS_BYTES = 147456;

typedef unsigned u32x2 __attribute__((ext_vector_type(2)));
typedef short s16x4 __attribute__((ext_vector_type(4)));
typedef float f32x2s __attribute__((ext_vector_type(2)));
typedef LAS unsigned char* ldsp;

struct Frame { ldsp lds; int tid, lane, wave, vcu, G; };

__device__ __forceinline__ float wave_sum(float v) {
#pragma unroll
    for (int o = 1; o < 64; o <<= 1) v += __shfl_xor(v, o);
    return v;
}
__device__ __forceinline__ float fexp2(float x) { return __builtin_amdgcn_exp2f(x); }
__device__ __forceinline__ float silu_f(float x) { return x * __builtin_amdgcn_rcpf(1.0f + fexp2(-1.4426950408889634f * x)); }
__device__ __forceinline__ float bf_lo(unsigned w) { return __builtin_bit_cast(float, w << 16); }
__device__ __forceinline__ float bf_hi(unsigned w) { return __builtin_bit_cast(float, w & 0xffff0000u); }
__device__ __forceinline__ unsigned cvtpk(float lo, float hi) { return pg8::cvt_pk_bf16(lo, hi); }

__device__ __forceinline__ int src_col(int type, int n) {
    if (type == 0) return n;
    const int pn = n >> 8, bj = (n >> 7) & 1, t = n & 127;
    if (type == 1) return bj * DFF + (pn << 7) + t;
    if (pn < 4) { const int base = (pn < 2) ? 0 : 512; return base + (2 * (pn & 1) + (t >> 6)) * 128 + 64 * bj + (t & 63); }
    if (pn < 8) return n;
    if (pn < 12) return 2560 + bj * 512 + ((pn - 8) << 7) + t;
    return 2048 + (n - 3072);
}
__device__ __forceinline__ void p0_transpose_item(const float* W, int K, int N, bf16* WT, int type, LAS float* scr, int item, int lane) {
    const int nblk = N / 32, kb = item / nblk, nb = item % nblk, k0 = 64 * kb, n0 = 32 * nb;
    const int sc = src_col(type, n0 + (lane & 31));
#pragma unroll 8
    for (int i = 0; i < 32; ++i) { const int kk = 2 * i + (lane >> 5); scr[kk * 33 + (lane & 31)] = W[(size_t)(k0 + kk) * N + sc]; }
    LDS_WAIT(); asm volatile("" ::: "memory");
    const int c = lane & 7;
#pragma unroll
    for (int j = 0; j < 4; ++j) { const int n = (lane >> 3) + 8 * j; const LAS float* s = scr + (8 * c) * 33 + n;
        v4u o; o.x = pk2(s[0 * 33], s[1 * 33]); o.y = pk2(s[2 * 33], s[3 * 33]); o.z = pk2(s[4 * 33], s[5 * 33]); o.w = pk2(s[6 * 33], s[7 * 33]);
        *(GAS v4u*)(WT + (size_t)(n0 + n) * K + k0 + 8 * c) = o; }
    LDS_WAIT(); asm volatile("" ::: "memory");
}

struct Args { const float* in[21]; float* out; unsigned char* ws; int ph_lo, ph_hi; };

__device__ __forceinline__ void p0_prologue(const Frame& F, const Args& a) {
    {
        LAS float* scr = (LAS float*)(F.lds + F.wave * 16384);
        const int gw = F.vcu * NWAVES + F.wave, NGW = F.G * NWAVES;
        constexpr int I_FI = (D / 64) * (NFI / 32), I_FO = (DFF / 64) * (D / 32), I_IN = (D / 64) * (NIN / 32), I_OUT = (D / 64) * (D / 32);
        constexpr int I_LAYER = 2 * I_FI + 2 * I_FO + I_IN + I_OUT;
        for (int it = gw; it < DEPTH * I_LAYER; it += NGW) {
            const int l = it / I_LAYER; int r = it % I_LAYER;
            bf16* wl = (bf16*)(a.ws + WS_W + (size_t)l * W_LAYER);
            if (r < I_FI) { p0_transpose_item(a.in[9] + (size_t)l * D * NFI, D, NFI, (bf16*)((unsigned char*)wl + W_1I), 1, scr, r, F.lane); continue; } r -= I_FI;
            if (r < I_FO) { p0_transpose_item(a.in[10] + (size_t)l * DFF * D, DFF, D, (bf16*)((unsigned char*)wl + W_1O), 0, scr, r, F.lane); continue; } r -= I_FO;
            if (r < I_IN) { p0_transpose_item(a.in[12] + (size_t)l * D * NIN, D, NIN, (bf16*)((unsigned char*)wl + W_IN), 2, scr, r, F.lane); continue; } r -= I_IN;
            if (r < I_OUT) { p0_transpose_item(a.in[16] + (size_t)l * D * D, D, D, (bf16*)((unsigned char*)wl + W_OUT), 0, scr, r, F.lane); continue; } r -= I_OUT;
            if (r < I_FI) { p0_transpose_item(a.in[18] + (size_t)l * D * NFI, D, NFI, (bf16*)((unsigned char*)wl + W_2I), 1, scr, r, F.lane); continue; } r -= I_FI;
            p0_transpose_item(a.in[19] + (size_t)l * DFF * D, DFF, D, (bf16*)((unsigned char*)wl + W_2O), 0, scr, r, F.lane);
        }
    }
    {
        float* rc = (float*)(a.ws + WS_ROPE); float* rs = rc + 8192 * 64;
        for (int idx = F.vcu * 512 + F.tid; idx < 8192 * 64; idx += F.G * 512) {
            const int pos = idx >> 6, i = idx & 63;
            double inv = 1.0; for (int q = 0; q < i; ++q) inv *= 0.8659643233600653;
            const double ang = (double)pos * inv;
            const double rev = ang * 0.15915494309189535; const double fr = rev - __builtin_rint(rev);
            const float r = (float)(fr * 6.283185307179586);
            rc[idx] = __cosf(r); rs[idx] = __sinf(r);
        }
    }
    __syncthreads();
    {
        LAS float* sc = (LAS float*)F.lds;
        LAS float* red = (LAS float*)(F.lds + 65536);
        for (int e = F.tid; e < 16 * D; e += 512) { const int bb = e >> 10, k = e & 1023; const float v = (bb < 8) ? a.in[2][bb * D + k] : a.in[3][(bb - 8) * D + k]; sc[k * 16 + bb] = silu_f(v); }
        __syncthreads();
        float* mod = (float*)(a.ws + WS_MOD);
        constexpr int NITEM = DEPTH * (MODW / 64);
        for (int it = F.vcu; it < NITEM; it += F.G) {
            const int l = it / (MODW / 64), n0 = (it % (MODW / 64)) * 64;
            const float* w = a.in[6] + (size_t)l * D * MODW + n0 + F.lane;
            float acc[16];
#pragma unroll
            for (int bb = 0; bb < 16; ++bb) acc[bb] = 0.f;
            const int k0 = F.wave * 128;
#pragma unroll 4
            for (int k = 0; k < 128; ++k) {
                const float wv = w[(size_t)(k0 + k) * MODW];
                const LAS f32x4* s4 = (const LAS f32x4*)(sc + (k0 + k) * 16);
                const f32x4 s0 = s4[0], s1 = s4[1], s2 = s4[2], s3 = s4[3];
                acc[0] += s0.x * wv; acc[1] += s0.y * wv; acc[2] += s0.z * wv; acc[3] += s0.w * wv;
                acc[4] += s1.x * wv; acc[5] += s1.y * wv; acc[6] += s1.z * wv; acc[7] += s1.w * wv;
                acc[8] += s2.x * wv; acc[9] += s2.y * wv; acc[10] += s2.z * wv; acc[11] += s2.w * wv;
                acc[12] += s3.x * wv; acc[13] += s3.y * wv; acc[14] += s3.z * wv; acc[15] += s3.w * wv;
            }
#pragma unroll
            for (int bb = 0; bb < 16; ++bb) red[(F.wave * 16 + bb) * 64 + F.lane] = acc[bb];
            __syncthreads();
            for (int o = F.tid; o < 16 * 64; o += 512) { const int bb = o >> 6, c = o & 63; float s = a.in[7][(size_t)l * MODW + n0 + c];
#pragma unroll
                for (int w8 = 0; w8 < 8; ++w8) s += red[(w8 * 16 + bb) * 64 + c];
                mod[((size_t)l * 16 + bb) * MODW + n0 + c] = s; }
            __syncthreads();
        }
    }
}

__device__ __forceinline__ void norm_phase(const Frame& F, const float* xP, const float* xS, const float* g, const float* modl, int ishift, bf16* H) {
    const int gw = F.vcu * NWAVES + F.wave, NGW = F.G * NWAVES;
    for (int row = gw; row < MT; row += NGW) {
        const float* xr = (row < MP) ? xP + (size_t)row * D : xS + (size_t)(row - MP) * D;
        const int bb = (row < MP) ? (row >> 13) : 8 + ((row - MP) >> 5);
        const GAS f32x4* x4 = (const GAS f32x4*)xr + F.lane;
        f32x4 v[4]; float s = 0.f;
#pragma unroll
        for (int j = 0; j < 4; ++j) { v[j] = x4[64 * j]; s += (v[j].x * v[j].x + v[j].y * v[j].y) + (v[j].z * v[j].z + v[j].w * v[j].w); }
        const float rstd = 1.0f / sqrtf(wave_sum(s) * (1.0f / D) + EPS);
        const float* sh = modl + (size_t)bb * MODW + (size_t)ishift * D; const float* sc = sh + D;
        GAS u32x2* o8 = (GAS u32x2*)(H + (size_t)row * D) + F.lane;
#pragma unroll
        for (int j = 0; j < 4; ++j) {
            const int c = 4 * F.lane + 256 * j;
            const f32x4 gv = *(const f32x4*)(g + c), sv = *(const f32x4*)(sc + c), hv = *(const f32x4*)(sh + c);
            f32x4 y = (v[j] * rstd) * gv; y = y * (sv + 1.0f) + hv;
            u32x2 o; o.x = cvtpk(y.x, y.y); o.y = cvtpk(y.z, y.w); o8[64 * j] = o;
        }
    }
}
__device__ __forceinline__ void final_norm_phase(const Frame& F, float* X, const float* g) {
    const int gw = F.vcu * NWAVES + F.wave, NGW = F.G * NWAVES;
    for (int row = gw; row < MT; row += NGW) {
        GAS f32x4* x4 = (GAS f32x4*)(X + (size_t)row * D) + F.lane;
        f32x4 v[4]; float s = 0.f;
#pragma unroll
        for (int j = 0; j < 4; ++j) { v[j] = x4[64 * j]; s += (v[j].x * v[j].x + v[j].y * v[j].y) + (v[j].z * v[j].z + v[j].w * v[j].w); }
        const float rstd = 1.0f / sqrtf(wave_sum(s) * (1.0f / D) + EPS);
#pragma unroll
        for (int j = 0; j < 4; ++j) { const f32x4 gv = *(const f32x4*)(g + 4 * F.lane + 256 * j); x4[64 * j] = (v[j] * rstd) * gv; }
    }
}

using pg8::Unit;
struct EpiFFN {
    static constexpr bool PERM = true, AFTER_DRAIN = false;
    bf16* ACT;
    __device__ __forceinline__ void operator()(const f32x4 (&acc)[2][2][4][2], const Unit& u, int wr, int wc, int fr, int fq) const {
        asm volatile("" : "+v"(fr), "+v"(fq));
        const int row0 = u.pm * 256 + wr * 64 + fr, col0 = u.pn * 128 + wc * 32 + 8 * fq;
#pragma unroll
        for (int ai = 0; ai < 2; ++ai)
#pragma unroll
            for (int m = 0; m < 4; ++m) {
                const f32x4 g0 = acc[ai][0][m][0], g1 = acc[ai][0][m][1], u0 = acc[ai][1][m][0], u1 = acc[ai][1][m][1];
                v4u w;
                w.x = cvtpk(silu_f(g0.x) * u0.x, silu_f(g0.y) * u0.y); w.y = cvtpk(silu_f(g0.z) * u0.z, silu_f(g0.w) * u0.w);
                w.z = cvtpk(silu_f(g1.x) * u1.x, silu_f(g1.y) * u1.y); w.w = cvtpk(silu_f(g1.z) * u1.z, silu_f(g1.w) * u1.w);
                *(GAS v4u*)(ACT + (size_t)(row0 + ai * 128 + m * 16) * DFF + col0) = w;
                asm volatile("" ::: "memory");
            }
    }
};
struct EpiRes {
    static constexpr bool PERM = false, AFTER_DRAIN = false;
    const float* xP; const float* xS; float* X; const float* gate; float coef;
    __device__ __forceinline__ void operator()(const f32x4 (&acc)[2][2][4][2], const Unit& u, int wr, int wc, int fr, int fq) const {
        asm volatile("" : "+v"(fr), "+v"(fq));
        const int col0 = u.pn * 256 + wc * 32 + 4 * fq;
#pragma unroll
        for (int ai = 0; ai < 2; ++ai)
#pragma unroll
            for (int m = 0; m < 4; ++m) {
                const int lrow = ai * 128 + wr * 64 + m * 16 + fr, row = u.pm * 256 + lrow;
                const int bb = (u.pm < 256) ? (u.pm >> 5) : 8 + (lrow >> 5);
                const float* xo = ((u.pm < 256) ? xP + (size_t)row * D : xS + (size_t)(row - MP) * D) + col0;
                const float* gp = gate + (size_t)bb * MODW + col0;
                float* xn = X + (size_t)row * D + col0;
#pragma unroll
                for (int bj = 0; bj < 2; ++bj)
#pragma unroll
                    for (int n = 0; n < 2; ++n) {
                        const int o = bj * 128 + n * 16;
                        const f32x4 gv = *(const f32x4*)(gp + o), xv = *(const f32x4*)(xo + o);
                        *(f32x4*)(xn + o) = xv + (gv * coef) * acc[ai][bj][m][n];
                    }
                asm volatile("" ::: "memory");
            }
    }
};
struct EpiMix {
    static constexpr bool PERM = true, AFTER_DRAIN = false;
    bf16* base6; const float* rcos; const float* rsin; float* scP; float* scS;
    __device__ __forceinline__ void operator()(const f32x4 (&acc)[2][2][4][2], const Unit& u, int wr, int wc, int fr, int fq) const {
        asm volatile("" : "+v"(fr), "+v"(fq));
        const int pn = u.pn, t0 = wc * 32 + 8 * fq;
#pragma unroll
        for (int ai = 0; ai < 2; ++ai)
#pragma unroll
            for (int m = 0; m < 4; ++m) {
                const int lrow = ai * 128 + wr * 64 + m * 16 + fr, row = u.pm * 256 + lrow;
                const int pos = (u.pm < 256) ? (row & (SEQ - 1)) : PAST + (lrow & 31);
                if (pn < 4) {
                    const int head = 2 * (pn & 1) + (wc >> 1), dd0 = (wc & 1) * 32 + 8 * fq;
                    const float sclk = (pn < 2) ? 1.0f : 0.08838834764831845f;
                    const f32x4 c0 = *(const f32x4*)(rcos + pos * 64 + dd0), c1 = *(const f32x4*)(rcos + pos * 64 + dd0 + 4);
                    const f32x4 s0 = *(const f32x4*)(rsin + pos * 64 + dd0), s1 = *(const f32x4*)(rsin + pos * 64 + dd0 + 4);
                    const f32x4 a0 = acc[ai][0][m][0], a1 = acc[ai][0][m][1], b0 = acc[ai][1][m][0], b1 = acc[ai][1][m][1];
                    const f32x4 o10 = (a0 * c0 - b0 * s0) * sclk, o11 = (a1 * c1 - b1 * s1) * sclk, o20 = (a0 * s0 + b0 * c0) * sclk, o21 = (a1 * s1 + b1 * c1) * sclk;
                    bf16* dst = base6 + (size_t)(pn >> 1) * (SZ_M512 / 2) + (size_t)row * RET + head * HD + dd0;
                    v4u w1, w2; w1.x = cvtpk(o10.x, o10.y); w1.y = cvtpk(o10.z, o10.w); w1.z = cvtpk(o11.x, o11.y); w1.w = cvtpk(o11.z, o11.w);
                    w2.x = cvtpk(o20.x, o20.y); w2.y = cvtpk(o20.z, o20.w); w2.z = cvtpk(o21.x, o21.y); w2.w = cvtpk(o21.z, o21.w);
                    *(GAS v4u*)dst = w1; *(GAS v4u*)(dst + 64) = w2;
                } else if (pn < 8 || pn >= 12) {
                    const int bi = (pn < 8) ? (pn >> 1) : 4;
                    bf16* dst = base6 + (size_t)bi * (SZ_M512 / 2) + (size_t)row * 512 + (pn & 1) * 256 + t0;
#pragma unroll
                    for (int bj = 0; bj < 2; ++bj) { const f32x4 a0 = acc[ai][bj][m][0], a1 = acc[ai][bj][m][1];
                        v4u w; w.x = cvtpk(a0.x, a0.y); w.y = cvtpk(a0.z, a0.w); w.z = cvtpk(a1.x, a1.y); w.w = cvtpk(a1.z, a1.w);
                        *(GAS v4u*)(dst + bj * 128) = w; }
                } else {
                    const int ch0 = (pn - 8) * 128 + t0;
                    const f32x4 p0 = acc[ai][0][m][0] * acc[ai][1][m][0], p1 = acc[ai][0][m][1] * acc[ai][1][m][1];
                    v4u w; w.x = cvtpk(p0.x, p0.y); w.y = cvtpk(p0.z, p0.w); w.z = cvtpk(p1.x, p1.y); w.w = cvtpk(p1.z, p1.w);
                    *(GAS v4u*)(base6 + (size_t)5 * (SZ_M512 / 2) + (size_t)row * 512 + ch0) = w;
                    if (u.pm < 256) { if (pos >= SEQ - 2) { float* d = scP + ((size_t)(row >> 13) * 2 + (pos - (SEQ - 2))) * CONVD + ch0; *(f32x4*)d = p0; *(f32x4*)(d + 4) = p1; } }
                    else { const int lp = lrow & 31; if (lp >= DSEQ - 2) { float* d = scS + ((size_t)(lrow >> 5) * 2 + (lp - (DSEQ - 2))) * CONVD + ch0; *(f32x4*)d = p0; *(f32x4*)(d + 4) = p1; } }
                }
                asm volatile("" ::: "memory");
            }
    }
};

struct RetArgs { const bf16 *Q, *K, *V, *Gt; bf16* MIX; float* T; const float* gn; const float* Sin; float* SoutP; float* SoutS; };
constexpr int RL_Q = 0, RL_K = 17408, RL_KD = 34816, RL_V = 52224, RL_P = 69632, RL_ST = 78848;
__device__ __forceinline__ s16x4 tr_read(ldsp p) { typedef short v4i16_t __attribute__((ext_vector_type(4))); return __builtin_bit_cast(s16x4, __builtin_amdgcn_ds_read_tr16_b64_v4i16((LAS v4i16_t*)p)); }
__device__ __forceinline__ bf16x8 cat4(s16x4 lo, s16x4 hi) { bf16x8 r; r[0] = lo[0]; r[1] = lo[1]; r[2] = lo[2]; r[3] = lo[3]; r[4] = hi[0]; r[5] = hi[1]; r[6] = hi[2]; r[7] = hi[3]; return r; }
__device__ __forceinline__ v4u scale8(v4u k, float s) {
    v4u r; r.x = cvtpk(bf_lo(k.x) * s, bf_hi(k.x) * s); r.y = cvtpk(bf_lo(k.y) * s, bf_hi(k.y) * s); r.z = cvtpk(bf_lo(k.z) * s, bf_hi(k.z) * s); r.w = cvtpk(bf_lo(k.w) * s, bf_hi(k.w) * s); return r; }

template <int L, bool FULL>
__device__ __forceinline__ void ret_item(const Frame& F, const RetArgs& R, int row0, int h, int nch, f32x4 (&S)[8], float lg2) {
    constexpr int NB = L / 16, KS = L / 32, NLD = L / 32;
    const int wave = F.wave, lr = F.tid >> 4, c16 = F.tid & 15;
    const ldsp lds = F.lds;
    v4u rq[NLD], rk[NLD], rv[NLD];
#define RET_GLOAD(ch) do { _Pragma("unroll") for (int i = 0; i < NLD; ++i) { const size_t off = (size_t)(row0 + (ch) * L + lr + 32 * i) * RET + h * HD + c16 * 8; \
        if (FULL) rq[i] = *(const GAS v4u*)(R.Q + off); rk[i] = *(const GAS v4u*)(R.K + off); rv[i] = *(const GAS v4u*)(R.V + off); } } while (0)
    RET_GLOAD(0);
    const float gL = fexp2(lg2 * (float)L);
    for (int ch = 0; ch < nch; ++ch) {
        int lane = F.lane; asm volatile("" : "+v"(lane));
        const int fr = lane & 15, fq = lane >> 4;
        const int b272 = fr * 272 + fq * 16, bq8 = fr * 272 + fq * 8, btr = (fq * 8 + (fr >> 2)) * 272 + (fr & 3) * 8, b144w = fr * 144 + fq * 8, b144r = fr * 144 + fq * 16, bst = fr * 64;
        {   int tl = F.tid; asm volatile("" : "+v"(tl)); const int ow = (tl >> 4) * 272 + (tl & 15) * 16;
#pragma unroll
            for (int i = 0; i < NLD; ++i) { const int j = (tl >> 4) + 32 * i; const int o = ow + i * 32 * 272;
                if (FULL) { *(LAS v4u*)(lds + RL_Q + o) = rq[i]; *(LAS v4u*)(lds + RL_K + o) = rk[i]; }
                *(LAS v4u*)(lds + RL_KD + o) = scale8(rk[i], fexp2(lg2 * (float)(L - 1 - j)));
                *(LAS v4u*)(lds + RL_V + o) = rv[i]; } }
        LDS_WAIT(); __syncthreads();
        if (ch + 1 < nch) RET_GLOAD(ch + 1);
        f32x4 o[NB];
        bf16x8 vf[KS];
        if (FULL) {
            for (int blk = wave; blk < NB * NB; blk += 8) {
                const int ib = blk / NB, jb = blk % NB;
                f32x4 acc = {0.f, 0.f, 0.f, 0.f};
                const ldsp kp = lds + RL_K + jb * (16 * 272) + b272, qp = lds + RL_Q + ib * (16 * 272) + b272;
#pragma unroll
                for (int s = 0; s < 4; ++s) {
                    const bf16x8 ka = *(const LAS bf16x8*)(kp + s * 64);
                    const bf16x8 qb = *(const LAS bf16x8*)(qp + s * 64);
                    acc = __builtin_amdgcn_mfma_f32_16x16x32_bf16(ka, qb, acc, 0, 0, 0);
                }
                const int dij = (ib - jb) * 16 + fr - fq * 4;
                float p[4];
#pragma unroll
                for (int t = 0; t < 4; ++t) { const int dj = dij - t; p[t] = acc[t] * fexp2(lg2 * (float)(dj < 0 ? -dj : dj)); }
                u32x2 w; w.x = cvtpk(p[0], p[1]); w.y = cvtpk(p[2], p[3]);
                *(LAS u32x2*)(lds + RL_P + ib * (16 * 144) + jb * 32 + b144w) = w;
            }
            LDS_WAIT(); __syncthreads();
        }
        __builtin_amdgcn_sched_barrier(0);
        {   const ldsp p = lds + RL_V + wave * 32 + btr;
#pragma unroll
            for (int ks = 0; ks < KS; ++ks) vf[ks] = cat4(tr_read(p + ks * (32 * 272)), tr_read(p + ks * (32 * 272) + 4 * 272)); }
        if (FULL) {
            __builtin_amdgcn_sched_barrier(0);
            bf16x8 sf[4];
#pragma unroll
            for (int s = 0; s < 4; ++s) { v4u w; w.x = cvtpk(S[2 * s][0], S[2 * s][1]); w.y = cvtpk(S[2 * s][2], S[2 * s][3]); w.z = cvtpk(S[2 * s + 1][0], S[2 * s + 1][1]); w.w = cvtpk(S[2 * s + 1][2], S[2 * s + 1][3]);
                sf[s] = __builtin_bit_cast(bf16x8, w); }
            const float cdl = lg2 * (float)(fr + 1);
#pragma unroll
            for (int ib = 0; ib < NB; ++ib) {
                f32x4 acc = {0.f, 0.f, 0.f, 0.f};
                const ldsp qrow = lds + RL_Q + ib * (16 * 272) + bq8;
#pragma unroll
                for (int s = 0; s < 4; ++s) {
                    const u32x2 lo = *(const LAS u32x2*)(qrow + (2 * s) * 32), hi = *(const LAS u32x2*)(qrow + (2 * s + 1) * 32);
                    v4u w; w.x = lo.x; w.y = lo.y; w.z = hi.x; w.w = hi.y;
                    acc = __builtin_amdgcn_mfma_f32_16x16x32_bf16(sf[s], __builtin_bit_cast(bf16x8, w), acc, 0, 0, 0);
                }
                acc = acc * fexp2(cdl + lg2 * (float)(ib * 16));
                const ldsp pp = lds + RL_P + ib * (16 * 144) + b144r;
#pragma unroll
                for (int ks = 0; ks < KS; ++ks) {
                    const bf16x8 pb = *(const LAS bf16x8*)(pp + ks * 64);
                    acc = __builtin_amdgcn_mfma_f32_16x16x32_bf16(vf[ks], pb, acc, 0, 0, 0);
                }
                o[ib] = acc;
                asm volatile("" ::: "memory");
            }
        }
        __builtin_amdgcn_sched_barrier(0);
        {   const ldsp kd = lds + RL_KD + btr;
#pragma unroll
            for (int db = 0; db < 8; ++db) {
                f32x4 acc = S[db] * gL;
#pragma unroll
                for (int ks = 0; ks < KS; ++ks) { const ldsp p = kd + db * 32 + ks * (32 * 272);
                    acc = __builtin_amdgcn_mfma_f32_16x16x32_bf16(cat4(tr_read(p), tr_read(p + 4 * 272)), vf[ks], acc, 0, 0, 0); }
                S[db] = acc;
                if (db & 1) asm volatile("" ::: "memory");
            } }
        __builtin_amdgcn_sched_barrier(0);
        if (FULL) {
#pragma unroll
            for (int ib = 0; ib < NB; ++ib) {
                float s1 = (o[ib][0] + o[ib][1]) + (o[ib][2] + o[ib][3]);
                float s2 = (o[ib][0] * o[ib][0] + o[ib][1] * o[ib][1]) + (o[ib][2] * o[ib][2] + o[ib][3] * o[ib][3]);
                s1 += __shfl_xor(s1, 16); s1 += __shfl_xor(s1, 32); s2 += __shfl_xor(s2, 16); s2 += __shfl_xor(s2, 32);
                if (fq == 0) { f32x2s w; w.x = s1; w.y = s2; *(LAS f32x2s*)(lds + RL_ST + ib * 1024 + wave * 8 + bst) = w; }
            }
            LDS_WAIT(); __syncthreads();
            const int e0 = wave * 16 + fq * 4;
            const f32x4 gnv = *(const f32x4*)(R.gn + h * HD + e0);
#pragma unroll
            for (int ib = 0; ib < NB; ++ib) {
                float s1 = 0.f, s2 = 0.f;
#pragma unroll
                for (int w8 = 0; w8 < 8; ++w8) { const f32x2s w = *(const LAS f32x2s*)(lds + RL_ST + ib * 1024 + w8 * 8 + bst); s1 += w.x; s2 += w.y; }
                const float mu = s1 * (1.0f / HD); float var = s2 * (1.0f / HD) - mu * mu; var = var < 0.f ? 0.f : var;
                const float rstd = 1.0f / sqrtf(var + EPS);
                const size_t row = (size_t)(row0 + ch * L + ib * 16 + fr);
                const u32x2 gw = *(const GAS u32x2*)(R.Gt + row * RET + h * HD + e0);
                const float y0 = silu_f(bf_lo(gw.x)) * ((o[ib][0] - mu) * rstd * gnv.x), y1 = silu_f(bf_hi(gw.x)) * ((o[ib][1] - mu) * rstd * gnv.y);
                const float y2 = silu_f(bf_lo(gw.y)) * ((o[ib][2] - mu) * rstd * gnv.z), y3 = silu_f(bf_hi(gw.y)) * ((o[ib][3] - mu) * rstd * gnv.w);
                u32x2 w; w.x = cvtpk(y0, y1); w.y = cvtpk(y2, y3);
                *(GAS u32x2*)(R.MIX + row * D + h * HD + e0) = w;
                asm volatile("" ::: "memory");
            }
        } else {
            LDS_WAIT(); __syncthreads();
        }
    }
#undef RET_GLOAD
}

__device__ __forceinline__ float lg2_of_head(int h) { return h == 0 ? -0.04580368961312479f : h == 1 ? -0.02272007650008353f : h == 2 ? -0.011315313227834146f : -0.005646563141142063f; }

__device__ __forceinline__ void ret_phase_a(const Frame& F, const RetArgs& R) {
    for (int v = F.vcu; v < 256; v += F.G) {
        const int bh = v >> 3, s = v & 7, b = bh >> 2, h = bh & 3; const float lg2 = lg2_of_head(h);
        for (int half = 0; half < 2; ++half) {
            const int sc = half ? 15 - s : s; if (sc == 15) continue;
            f32x4 S[8];
#pragma unroll
            for (int db = 0; db < 8; ++db) S[db] = (f32x4){0.f, 0.f, 0.f, 0.f};
            ret_item<64, false>(F, R, b * SEQ + sc * 512, h, 8, S, lg2);
            float* T = R.T + (size_t)(bh * 16 + sc) * 16384;
#pragma unroll
            for (int db = 0; db < 8; ++db) *(GAS f32x4*)(T + ((F.wave * 8 + db) * 64 + F.lane) * 4) = S[db];
        }
    }
}
#define LAUNDER_FRFQ() int ln_ = F.lane; asm volatile("" : "+v"(ln_)); const int fr = ln_ & 15, fq = ln_ >> 4
__device__ __forceinline__ void ret_phase_c(const Frame& F, const RetArgs& R) {
    for (int v = F.vcu; v < 256; v += F.G) {
        const int bh = v >> 3, s = v & 7, b = bh >> 2, h = bh & 3; const float lg2 = lg2_of_head(h); const float g512 = fexp2(lg2 * 512.f);
        for (int half = 0; half < 2; ++half) {
            const int sc = half ? 15 - s : s;
            f32x4 S[8];
#pragma unroll
            for (int db = 0; db < 8; ++db) S[db] = (f32x4){0.f, 0.f, 0.f, 0.f};
            for (int p = 0; p < sc; ++p) { const float* T = R.T + (size_t)(bh * 16 + p) * 16384;
#pragma unroll
                for (int db = 0; db < 8; ++db) S[db] = S[db] * g512 + *(const GAS f32x4*)(T + ((F.wave * 8 + db) * 64 + F.lane) * 4); }
            ret_item<64, true>(F, R, b * SEQ + sc * 512, h, 8, S, lg2);
            if (sc == 15) { LAUNDER_FRFQ(); float* So = R.SoutP + (size_t)bh * 16384;
#pragma unroll
                for (int db = 0; db < 8; ++db)
#pragma unroll
                    for (int t = 0; t < 4; ++t) So[(db * 16 + fq * 4 + t) * HD + F.wave * 16 + fr] = S[db][t]; }
        }
        if (v < 32) {
            const float* Si = R.Sin + (size_t)v * 16384; f32x4 S[8];
            { LAUNDER_FRFQ();
#pragma unroll
            for (int db = 0; db < 8; ++db)
#pragma unroll
                for (int t = 0; t < 4; ++t) S[db][t] = Si[(db * 16 + fq * 4 + t) * HD + F.wave * 16 + fr]; }
            ret_item<32, true>(F, R, MP + (v >> 2) * DSEQ, v & 3, 1, S, lg2_of_head(v & 3));
            LAUNDER_FRFQ(); float* So = R.SoutS + (size_t)v * 16384;
#pragma unroll
            for (int db = 0; db < 8; ++db)
#pragma unroll
                for (int t = 0; t < 4; ++t) So[(db * 16 + fq * 4 + t) * HD + F.wave * 16 + fr] = S[db][t];
        }
    }
}
__device__ __forceinline__ void conv_phase(const Frame& F, const bf16* U, const bf16* BG, const float* cw, const float* cb, const float* hist, bf16* MIX) {
    for (int idx = F.vcu * 512 + F.tid; idx < MT * 64; idx += F.G * 512) {
        const int row = idx >> 6, c8 = (idx & 63) * 8;
        int pos, bs = 0; if (row < MP) pos = row & (SEQ - 1); else { pos = (row - MP) & 31; bs = (row - MP) >> 5; }
        const bool smp = row >= MP;
        float u0[8], u1[8], u2[8], bg[8];
        { const v4u w = *(const GAS v4u*)(U + (size_t)row * 512 + c8); u0[0] = bf_lo(w.x); u0[1] = bf_hi(w.x); u0[2] = bf_lo(w.y); u0[3] = bf_hi(w.y); u0[4] = bf_lo(w.z); u0[5] = bf_hi(w.z); u0[6] = bf_lo(w.w); u0[7] = bf_hi(w.w); }
        { const v4u w = *(const GAS v4u*)(BG + (size_t)row * 512 + c8); bg[0] = bf_lo(w.x); bg[1] = bf_hi(w.x); bg[2] = bf_lo(w.y); bg[3] = bf_hi(w.y); bg[4] = bf_lo(w.z); bg[5] = bf_hi(w.z); bg[6] = bf_lo(w.w); bg[7] = bf_hi(w.w); }
        if (pos >= 1) { const v4u w = *(const GAS v4u*)(U + (size_t)(row - 1) * 512 + c8); u1[0] = bf_lo(w.x); u1[1] = bf_hi(w.x); u1[2] = bf_lo(w.y); u1[3] = bf_hi(w.y); u1[4] = bf_lo(w.z); u1[5] = bf_hi(w.z); u1[6] = bf_lo(w.w); u1[7] = bf_hi(w.w); }
        else {
#pragma unroll
            for (int q = 0; q < 8; ++q) u1[q] = smp ? hist[((size_t)bs * 2 + 1) * CONVD + c8 + q] : 0.f; }
        if (pos >= 2) { const v4u w = *(const GAS v4u*)(U + (size_t)(row - 2) * 512 + c8); u2[0] = bf_lo(w.x); u2[1] = bf_hi(w.x); u2[2] = bf_lo(w.y); u2[3] = bf_hi(w.y); u2[4] = bf_lo(w.z); u2[5] = bf_hi(w.z); u2[6] = bf_lo(w.w); u2[7] = bf_hi(w.w); }
        else {
#pragma unroll
            for (int q = 0; q < 8; ++q) u2[q] = smp ? hist[((size_t)bs * 2 + pos) * CONVD + c8 + q] : 0.f; }
        float y[8];
#pragma unroll
        for (int q = 0; q < 8; ++q) { const int c = c8 + q; y[q] = bg[q] * (cb[c] + cw[c] * u2[q] + cw[CONVD + c] * u1[q] + cw[2 * CONVD + c] * u0[q]); }
        v4u w; w.x = cvtpk(y[0], y[1]); w.y = cvtpk(y[2], y[3]); w.z = cvtpk(y[4], y[5]); w.w = cvtpk(y[6], y[7]);
        *(GAS v4u*)(MIX + (size_t)row * D + 512 + c8) = w;
    }
}

constexpr int NPHASE = 24;
#ifndef PG8_SP2
#define PG8_SP2 true
#endif
#ifndef PG8_ALIGN
#define PG8_ALIGN true
#endif

__global__ void __launch_bounds__(NWAVES * 64, 2) fwd_kernel(Args a) {
    extern __shared__ __attribute__((aligned(16))) unsigned char lds_raw[];
    Frame F;
    F.lds = (ldsp)lds_raw; F.tid = threadIdx.x; F.lane = F.tid & 63; F.wave = __builtin_amdgcn_readfirstlane(F.tid >> 6);
    F.G = gridDim.x; { const int bx = blockIdx.x; F.vcu = (F.G % 8 == 0) ? (bx % 8) * (F.G / 8) + bx / 8 : bx; }
    volatile LAS unsigned* MISC = (volatile LAS unsigned*)(F.lds + MISC_OFF);
    for (int u = F.tid; u < (LDS_BYTES - LDSCTL_OFF) / 4; u += NWAVES * 64) ((LAS unsigned*)(F.lds + LDSCTL_OFF))[u] = 0u;
    __syncthreads();
    const bool multi = (a.ph_hi - a.ph_lo) > 1;
    XcdBarrier bar; bar.bar = (unsigned*)(a.ws + WS_CTL) + CW_BAR; bar.x = 0; bar.st = nullptr;
    if (multi) bar = xcd_barrier_post((unsigned*)(a.ws + WS_CTL) + CW_BAR, MISC + 8);

    unsigned char* ws = a.ws;
    float* X = a.out;
    bf16* H = (bf16*)(ws + WS_H);
    bf16* ACT = (bf16*)(ws + WS_BIG);
    bf16* Qb = (bf16*)(ws + WS_BIG); bf16* Kb = (bf16*)(ws + WS_BIG + SZ_M512); bf16* Vb = (bf16*)(ws + WS_BIG + 2 * SZ_M512);
    bf16* Gb = (bf16*)(ws + WS_BIG + 3 * SZ_M512); bf16* BGb = (bf16*)(ws + WS_BIG + 4 * SZ_M512); bf16* Ub = (bf16*)(ws + WS_BIG + 5 * SZ_M512);
    const float* rcos = (const float*)(ws + WS_ROPE); const float* rsin = rcos + 8192 * 64;

    const Frame F0 = F;
    for (int ph = a.ph_lo; ph < a.ph_hi; ++ph) {
        { int t_ = F0.tid; asm volatile("" : "+v"(t_)); F.tid = t_; F.lane = t_ & 63; F.wave = __builtin_amdgcn_readfirstlane(t_ >> 6); }
        if (ph == 0) { p0_prologue(F, a); }
        else if (ph == NPHASE - 1) { final_norm_phase(F, X, a.in[20]); }
        else {
            const int l = (ph - 1) / 11, k = (ph - 1) % 11;
            const float* modl = (const float*)(ws + WS_MOD) + (size_t)l * 16 * MODW;
            const unsigned char* wl = ws + WS_W + (size_t)l * W_LAYER;
            const float* xP = (l == 0) ? a.in[0] : X; const float* xS = (l == 0) ? a.in[1] : X + (size_t)MP * D;
            if (k == 0) norm_phase(F, xP, xS, a.in[8] + l * D, modl, 0, H);
            else if (k == 3) norm_phase(F, X, X + (size_t)MP * D, a.in[11] + l * D, modl, 3, H);
            else if (k == 8) norm_phase(F, X, X + (size_t)MP * D, a.in[17] + l * D, modl, 6, H);
            else if (k == 1 || k == 9) {
                pg8::Gemm g{H, (const bf16*)(wl + (k == 1 ? W_1I : W_2I)), MT, NFI, D}; pg8::StaticOrder S; S.init(MT, NFI, F.G, (int)blockIdx.x);
                EpiFFN E{ACT};
                pg8::gemm_phase<EpiFFN, pg8::StaticOrder, PG8_ALIGN, PG8_SP2>(F.lds, g, S, E);
            } else if (k == 2 || k == 7 || k == 10) {
                const bool first = (k == 2);
                pg8::Gemm g{k == 7 ? H : ACT, (const bf16*)(wl + (k == 2 ? W_1O : k == 7 ? W_OUT : W_2O)), MT, D, k == 7 ? D : DFF};
                pg8::StaticOrder S; S.init(MT, D, F.G, (int)blockIdx.x);
                EpiRes E{first ? xP : X, first ? xS : X + (size_t)MP * D, X, modl + (k == 2 ? 2 : k == 7 ? 5 : 8) * D, k == 7 ? 1.0f : 0.5f};
                pg8::gemm_phase<EpiRes, pg8::StaticOrder, PG8_ALIGN, PG8_SP2>(F.lds, g, S, E);
            } else if (k == 4) {
                pg8::Gemm g{H, (const bf16*)(wl + W_IN), MT, NIN, D}; pg8::StaticOrder S; S.init(MT, NIN, F.G, (int)blockIdx.x);
                EpiMix E{Qb, rcos, rsin, a.out + OFF_SCP + (size_t)l * 8 * 2 * CONVD, a.out + OFF_SCS + (size_t)l * 8 * 2 * CONVD};
                pg8::gemm_phase<EpiMix, pg8::StaticOrder, PG8_ALIGN, PG8_SP2>(F.lds, g, S, E);
            } else {
                RetArgs R{Qb, Kb, Vb, Gb, H, (float*)(ws + WS_T), a.in[13] + l * RET, a.in[4] + (size_t)l * 8 * NHEAD * HD * HD,
                          a.out + OFF_SRP + (size_t)l * 8 * NHEAD * HD * HD, a.out + OFF_SRS + (size_t)l * 8 * NHEAD * HD * HD};
                if (k == 5) { ret_phase_a(F, R); conv_phase(F, Ub, BGb, a.in[14] + (size_t)l * 3 * CONVD, a.in[15] + (size_t)l * CONVD, a.in[5] + (size_t)l * 8 * 2 * CONVD, H); }
                else ret_phase_c(F, R);
            }
        }
        if (ph + 1 < a.ph_hi) {
            if (ph == a.ph_lo) { __threadfence(); cg::this_grid().sync(); }
            else xcd_barrier(bar);
        }
    }
}

#ifndef MK_SINGLE
#define MK_SINGLE 0
#endif
extern "C" void kernel_launch(void* const* d_in, const int* in_sizes, int n_in, void* d_out, int out_size, void* d_ws, size_t ws_size, hipStream_t stream) {
    static int grid = 0;
    if (grid == 0) {
        if (n_in != 21 || ws_size < WS_END) { fprintf(stderr, "kernel_launch: unexpected problem (n_in %d, ws %zu)\n", n_in, ws_size); grid = -1; return; }
        int dev = 0, cus = 0, per_cu = 0;
        if (hipGetDevice(&dev) != hipSuccess || hipDeviceGetAttribute(&cus, hipDeviceAttributeMultiprocessorCount, dev) != hipSuccess) { grid = -1; return; }
        if (hipFuncSetAttribute((const void*)fwd_kernel, hipFuncAttributeMaxDynamicSharedMemorySize, LDS_BYTES) != hipSuccess) { fprintf(stderr, "kernel_launch: hipFuncSetAttribute failed\n"); grid = -1; return; }
        if (hipOccupancyMaxActiveBlocksPerMultiprocessor(&per_cu, (const void*)fwd_kernel, NWAVES * 64, LDS_BYTES) != hipSuccess || per_cu < 1) { fprintf(stderr, "kernel_launch: occupancy query says %d\n", per_cu); per_cu = 1; }
        (void)hipGetLastError();
        grid = cus * per_cu;
    }
    if (grid < 0) return;
    (void)hipMemsetAsync((char*)d_ws + WS_CTL, 0, CTL_ZERO_BYTES, stream);
    Args a{};
    for (int i = 0; i < 21; ++i) a.in[i] = (const float*)d_in[i];
    a.out = (float*)d_out; a.ws = (unsigned char*)d_ws;
#if MK_SINGLE
    a.ph_lo = 0; a.ph_hi = NPHASE;
    void* args[] = {&a};
    hipError_t e = hipLaunchCooperativeKernel((const void*)fwd_kernel, dim3(grid), dim3(NWAVES * 64), args, LDS_BYTES, stream);
    if (e != hipSuccess) fprintf(stderr, "cooperative launch failed: %s (grid %d)\n", hipGetErrorString(e), grid);
#else
    for (int ph = 0; ph < NPHASE; ++ph) {
        a.ph_lo = ph; a.ph_hi = ph + 1;
        hipLaunchKernelGGL(fwd_kernel, dim3(grid), dim3(NWAVES * 64), LDS_BYTES, stream, a);
    }
#endif
}
```

```cpp
#include <hip/hip_runtime.h>
#include <hip/hip_cooperative_groups.h>
#include <cstdio>
#include <cstdint>
namespace cg = cooperative_groups;
#define MK_SINGLE 1
namespace pg8 {
#define PG8_LAS __attribute__((address_space(3)))
typedef unsigned short bf16_t;
typedef short bf16x8 __attribute__((ext_vector_type(8)));
typedef float f32x4 __attribute__((ext_vector_type(4)));
typedef unsigned u32x4 __attribute__((ext_vector_type(4)));
constexpr int BM = 256, BK = 64, HALF = 128, HTB = HALF * BK * 2  , STAGE_BYTES = 8 * HTB, NXCD = 8, WGM = 8;

__host__ __device__ __forceinline__ int lds_byte(int r, int c) { const int st = (r >> 4) * 2 + (c >> 5), rr = r & 15, cc = c & 31, ob = rr * 64 + cc * 2; return st * 1024 + (ob ^ (((ob >> 9) & 1) << 5)); }
__host__ __device__ __forceinline__ void stage_rc(int b, int& R, int& C) { const int st = b / 1024, sb = b % 1024, swz = sb ^ (((sb >> 9) & 1) << 5); R = (st >> 1) * 16 + swz / 64; C = (st & 1) * 32 + (swz % 64) / 2; }
__host__ __device__ __forceinline__ int perm32(int rho) { const int n = rho >> 4, i = rho & 15; return 8 * (i >> 2) + 4 * n + (i & 3); }

struct Unit { int pm, pn, kt0, nkt, tab; };
struct Gemm { const bf16_t* A; const bf16_t* Bt; int M, N, K; };

struct StaticOrder {
    int nM, nN, nwg, G, c, ntf;
    __host__ __device__ void init(int M, int N, int G_, int c_) { nM = M / BM; nN = N / BM; nwg = nM * nN; G = G_; c = c_; }
    __host__ __device__ bool next(int i, Unit& u) const {
        const long L = (long)i * G + c; if (L >= nwg) return false;
        int wgid = (int)L; { const int q = nwg / NXCD, r = nwg % NXCD, xcd = wgid % NXCD, off = wgid / NXCD; wgid = (xcd < r ? xcd * (q + 1) : r * (q + 1) + (xcd - r) * q) + off; }
        const int nig = WGM * nN, gid = wgid / nig, fm = gid * WGM, gsz = (nM - fm) < WGM ? (nM - fm) : WGM;
        u.pm = fm + ((wgid % nig) % gsz); u.pn = (wgid % nig) / gsz; u.kt0 = 0; u.nkt = ntf; return true;
    }
    __device__ __forceinline__ void a_ready(const Unit&) const {}
    __device__ __forceinline__ void done(const Unit&) const {}
};
__device__ __forceinline__ unsigned cvt_pk_bf16(float lo, float hi) { unsigned r; asm volatile("v_cvt_pk_bf16_f32 %0, %1, %2" : "=v"(r) : "v"(lo), "v"(hi)); return r; }
template <class Epi, class Sched, bool ALIGN_EPI = false, bool SP2 = false>
__device__ __forceinline__ void gemm_phase(PG8_LAS unsigned char* lds, const Gemm g, const Sched& S, const Epi& E) {
    int tid_l = threadIdx.x; asm volatile("" : "+v"(tid_l));
    const int tid = tid_l, wid = __builtin_amdgcn_readfirstlane(tid >> 6), lane = tid & 63, wr = wid >> 2, wc = wid & 3, fr = lane & 15, fq = lane >> 4;
    const int K = g.K; int nt;
    unsigned voffA[2], voffB[2];
#pragma unroll
    for (int i = 0; i < 2; ++i) { int R, C; stage_rc(tid * 16 + i * 8192, R, C); const int Rb = Epi::PERM ? ((R & ~31) + perm32(R & 31)) : R;
        voffA[i] = (unsigned)(R * K + C) * 2u; voffB[i] = (unsigned)(Rb * K + C) * 2u; }
    const size_t kstep = (size_t)(BK * 2);
    const size_t hstep = (size_t)HALF * K * 2;
    const size_t tstep = 2 * hstep;
    const unsigned ldsw = (unsigned)wid * 1024u;
    const int aoff = lds_byte(wr * 64 + fr, fq * 8), boff = lds_byte(wc * 32 + fr, fq * 8);
#define PG8_SA(b, h) (((b) * 2 + (h)) * HTB)
#define PG8_SB(b, h) ((4 + (b) * 2 + (h)) * HTB)
#define PG8_STAGE(bufoff, gbase, voff) do { _Pragma("unroll") for (int _i = 0; _i < 2; ++_i) \
        __builtin_amdgcn_global_load_lds((const unsigned*)((const char*)(gbase) + (voff)[_i]), (PG8_LAS unsigned*)(lds + (bufoff) + ldsw + _i * 8192), 16, 0, 0); } while (0)
#define PG8_LDA(dst, b, h) do { _Pragma("unroll") for (int m = 0; m < 4; ++m) _Pragma("unroll") for (int k = 0; k < 2; ++k) dst[m][k] = *(const PG8_LAS bf16x8*)(lds + PG8_SA(b, h) + aoff + m * 2048 + k * 1024); } while (0)
#define PG8_LDB(dst, b, h) do { _Pragma("unroll") for (int n = 0; n < 2; ++n) _Pragma("unroll") for (int k = 0; k < 2; ++k) dst[n][k] = *(const PG8_LAS bf16x8*)(lds + PG8_SB(b, h) + boff + n * 2048 + k * 1024); } while (0)
#define PG8_MMA(ai, bj, At, Bt) do { __builtin_amdgcn_s_setprio(1); _Pragma("unroll") for (int m = 0; m < 4; ++m) _Pragma("unroll") for (int n = 0; n < 2; ++n) _Pragma("unroll") for (int k = 0; k < 2; ++k) \
        acc[ai][bj][m][n] = __builtin_amdgcn_mfma_f32_16x16x32_bf16(Bt[n][k], At[m][k], acc[ai][bj][m][n], 0, 0, 0); __builtin_amdgcn_s_setprio(0); } while (0)
#define PG8_WAIT_V(n) asm volatile("s_waitcnt vmcnt(" #n ")" ::: "memory")
#define PG8_WAIT_L(n) asm volatile("s_waitcnt lgkmcnt(" #n ")" ::: "memory")
#define PG8_BAR __builtin_amdgcn_s_barrier()
#define PG8_SCHED __builtin_amdgcn_sched_barrier(0)
    Unit cur, nxt; int ui = 0;
    if (!S.next(0, cur)) return;
    nt = cur.nkt; cur.tab = 0; nxt.tab = 0;
    if constexpr (Epi::HAS_TAB) { cur.tab = E.tab_off(0); const float pv0 = E.pre_load(cur, wid, lane); E.pre_store(pv0, cur, wid, lane); }
    f32x4 acc[2][2][4][2];
#pragma unroll
    for (int a = 0; a < 2; ++a)
#pragma unroll
        for (int b = 0; b < 2; ++b)
#pragma unroll
            for (int m = 0; m < 4; ++m)
#pragma unroll
                for (int n = 0; n < 2; ++n) acc[a][b][m][n] = (f32x4){0.f, 0.f, 0.f, 0.f};
    bf16x8 At[4][2], B0[2][2], B1[2][2];
    const char* cA = (const char*)g.A + (size_t)cur.pm * tstep + (size_t)cur.kt0 * kstep; const char* cB = (const char*)g.Bt + (size_t)cur.pn * tstep + (size_t)cur.kt0 * kstep;
    S.a_ready(cur);
    if constexpr (SP2) {
        PG8_STAGE(PG8_SB(0, 0), cB, voffB); PG8_STAGE(PG8_SB(0, 1), cB + hstep, voffB); PG8_STAGE(PG8_SA(0, 0), cA, voffA); PG8_STAGE(PG8_SA(0, 1), cA + hstep, voffA);
        if (wr == 1) PG8_BAR;
        PG8_WAIT_V(2); PG8_BAR;
        PG8_STAGE(PG8_SB(1, 0), cB + kstep, voffB); PG8_STAGE(PG8_SA(1, 0), cA + kstep, voffA); PG8_STAGE(PG8_SB(1, 1), cB + hstep + kstep, voffB);
        PG8_WAIT_V(6); PG8_BAR;
    } else {
        PG8_STAGE(PG8_SB(0, 0), cB, voffB); PG8_STAGE(PG8_SA(0, 0), cA, voffA); PG8_STAGE(PG8_SB(0, 1), cB + hstep, voffB); PG8_STAGE(PG8_SA(0, 1), cA + hstep, voffA);
        if (wr == 1) PG8_BAR;
        PG8_WAIT_V(4); PG8_BAR;
        PG8_STAGE(PG8_SB(1, 0), cB + kstep, voffB); PG8_STAGE(PG8_SA(1, 0), cA + kstep, voffA); PG8_STAGE(PG8_SB(1, 1), cB + hstep + kstep, voffB);
        PG8_WAIT_V(6); PG8_BAR;
    }
    for (;;) {
        const bool has_next = S.next(ui + 1, nxt);
        if constexpr (Epi::HAS_TAB) nxt.tab = E.tab_off((ui + 1) & 1);
        const char* nA = has_next ? (const char*)g.A + (size_t)nxt.pm * tstep + (size_t)nxt.kt0 * kstep : cA; const char* nB = has_next ? (const char*)g.Bt + (size_t)nxt.pn * tstep + (size_t)nxt.kt0 * kstep : cB;
        for (int t = 0; t < nt; t += 2) {
            const bool last = (t == nt - 2);
            const char* a1 = cA + (size_t)(t + 1) * kstep;
            const char* a2 = last ? nA : cA + (size_t)(t + 2) * kstep; const char* b2 = last ? nB : cB + (size_t)(t + 2) * kstep;
            const char* a3 = a2 + kstep; const char* b3 = b2 + kstep;
            if (last && has_next) S.a_ready(nxt);
            if constexpr (SP2) {
            PG8_LDB(B0, 0, 0); PG8_LDB(B1, 0, 1); PG8_SCHED; PG8_LDA(At, 0, 0); PG8_STAGE(PG8_SA(1, 1), a1 + hstep, voffA);
            PG8_WAIT_V(8); PG8_WAIT_L(0); PG8_BAR; PG8_MMA(0, 0, At, B0); PG8_MMA(0, 1, At, B1); PG8_BAR; PG8_SCHED;
            PG8_LDA(At, 0, 1); PG8_STAGE(PG8_SB(0, 0), b2, voffB); PG8_STAGE(PG8_SB(0, 1), b2 + hstep, voffB); PG8_STAGE(PG8_SA(0, 0), a2, voffA);
            PG8_WAIT_V(8); PG8_WAIT_L(0); PG8_BAR; PG8_MMA(1, 0, At, B0); PG8_MMA(1, 1, At, B1); PG8_BAR; PG8_SCHED;
            PG8_LDB(B0, 1, 0); PG8_LDB(B1, 1, 1); PG8_SCHED; PG8_LDA(At, 1, 0); PG8_STAGE(PG8_SA(0, 1), a2 + hstep, voffA);
            PG8_WAIT_V(8); PG8_WAIT_L(0); PG8_BAR; PG8_MMA(0, 0, At, B0); PG8_MMA(0, 1, At, B1); PG8_BAR; PG8_SCHED;
            PG8_LDA(At, 1, 1); PG8_STAGE(PG8_SB(1, 0), b3, voffB); PG8_STAGE(PG8_SB(1, 1), b3 + hstep, voffB); PG8_STAGE(PG8_SA(1, 0), a3, voffA);
            PG8_WAIT_V(8); PG8_WAIT_L(0); PG8_BAR; PG8_MMA(1, 0, At, B0); PG8_MMA(1, 1, At, B1); PG8_BAR; PG8_SCHED;
            } else {
            PG8_LDB(B0, 0, 0); PG8_SCHED; PG8_LDA(At, 0, 0); PG8_STAGE(PG8_SA(1, 1), a1 + hstep, voffA);
            PG8_WAIT_L(8); PG8_BAR; PG8_WAIT_L(0); PG8_MMA(0, 0, At, B0); PG8_BAR; PG8_SCHED;
            PG8_LDB(B1, 0, 1); PG8_STAGE(PG8_SB(0, 0), b2, voffB);
            PG8_BAR; PG8_WAIT_L(0); PG8_MMA(0, 1, At, B1); PG8_BAR;
            PG8_LDA(At, 0, 1); PG8_STAGE(PG8_SA(0, 0), a2, voffA);
            PG8_BAR; PG8_WAIT_L(0); PG8_MMA(1, 0, At, B0); PG8_BAR; PG8_SCHED;
            PG8_STAGE(PG8_SB(0, 1), b2 + hstep, voffB);
            PG8_WAIT_V(6); PG8_BAR; PG8_MMA(1, 1, At, B1); PG8_BAR;
            PG8_LDB(B0, 1, 0); PG8_SCHED; PG8_LDA(At, 1, 0); PG8_STAGE(PG8_SA(0, 1), a2 + hstep, voffA);
            PG8_WAIT_L(8); PG8_BAR; PG8_WAIT_L(0); PG8_MMA(0, 0, At, B0); PG8_BAR; PG8_SCHED;
            PG8_LDB(B1, 1, 1); PG8_STAGE(PG8_SB(1, 0), b3, voffB);
            PG8_BAR; PG8_WAIT_L(0); PG8_MMA(0, 1, At, B1); PG8_BAR;
            PG8_LDA(At, 1, 1); PG8_STAGE(PG8_SA(1, 0), a3, voffA);
            PG8_BAR; PG8_WAIT_L(0); PG8_MMA(1, 0, At, B0); PG8_BAR; PG8_SCHED;
            PG8_STAGE(PG8_SB(1, 1), b3 + hstep, voffB);
            PG8_WAIT_V(6); PG8_BAR; PG8_MMA(1, 1, At, B1); PG8_BAR;
            }
        }
        if constexpr (ALIGN_EPI) { if (wr == 0) PG8_BAR; }
        if constexpr (!Epi::AFTER_DRAIN) {
            float pv = 0.f; if constexpr (Epi::HAS_TAB) { if (has_next) pv = E.pre_load(nxt, wid, lane); }
            E(acc, cur, wr, wc, fr, fq);
            if constexpr (Epi::HAS_TAB) { if (has_next) E.pre_store(pv, nxt, wid, lane); }
            S.done(cur); }
        if (!has_next) break;
#pragma unroll
        for (int a = 0; a < 2; ++a)
#pragma unroll
            for (int b = 0; b < 2; ++b)
#pragma unroll
                for (int m = 0; m < 4; ++m)
#pragma unroll
                    for (int n = 0; n < 2; ++n) acc[a][b][m][n] = (f32x4){0.f, 0.f, 0.f, 0.f};
        cur = nxt; cA = nA; cB = nB; ++ui; nt = cur.nkt;
        if constexpr (ALIGN_EPI) { if (wr == 1) PG8_BAR; }
    }
    PG8_WAIT_V(0);
    if constexpr (!ALIGN_EPI) { if (wr == 0) PG8_BAR; }
    PG8_BAR;
    if constexpr (Epi::AFTER_DRAIN) { E.fused(acc, cur, wr, wc, fr, fq, lds, wid, lane); S.done(cur); }
#undef PG8_SA
#undef PG8_SB
#undef PG8_STAGE
#undef PG8_LDA
#undef PG8_LDB
#undef PG8_MMA
#undef PG8_WAIT_V
#undef PG8_WAIT_L
#undef PG8_BAR
#undef PG8_SCHED
}
}
#define GAS __attribute__((address_space(1)))
#define LAS __attribute__((address_space(3)))
typedef unsigned short bf16;
typedef unsigned v4u __attribute__((ext_vector_type(4)));
typedef float f32x4 __attribute__((ext_vector_type(4)));
typedef short bf16x8 __attribute__((ext_vector_type(8)));
typedef GAS unsigned gu32;
typedef GAS unsigned long long gu64;
#define RLX_AGENT __ATOMIC_RELAXED, __HIP_MEMORY_SCOPE_AGENT
#define LDS_WAIT() asm volatile("s_waitcnt lgkmcnt(0)" ::: "memory")
#define VM_WAIT() asm volatile("s_waitcnt vmcnt(0)" ::: "memory")
__device__ __forceinline__ unsigned long long rt() { return __builtin_amdgcn_s_memrealtime(); }
__device__ __forceinline__ unsigned f2bf(float f) { unsigned u = __builtin_bit_cast(unsigned, f); return (u + 0x7fffu + ((u >> 16) & 1u)) >> 16; }
__device__ __forceinline__ unsigned pk2(float lo, float hi) { return f2bf(lo) | (f2bf(hi) << 16); }

#define XB_TMO      128
#define XB_XCNT(j)  (256  + 64 * (j))
#define XB_XSUB(j)  (1280 + 64 * (j))
#define XB_XGEN(j)  (2304 + 64 * (j))
#define XB_TOP      3328
#define XB_TOPGEN   3392
#define XCD_BAR_WORDS 3456
#define XB_SPIN_CAP (1u << 18)

__device__ __forceinline__ unsigned xb_ld(unsigned* p)              { return __hip_atomic_load(p, __ATOMIC_RELAXED, __HIP_MEMORY_SCOPE_AGENT); }
__device__ __forceinline__ unsigned xb_add(unsigned* p, unsigned v) { return __hip_atomic_fetch_add(p, v, __ATOMIC_RELAXED, __HIP_MEMORY_SCOPE_AGENT); }
__device__ __forceinline__ unsigned xb_xcc_id() { return (unsigned)__builtin_amdgcn_s_getreg((3 << 11) | 20) & 0xFu; }
#define XB_SPIN(cond, bar) do { unsigned _sp = 0; while (cond) { __builtin_amdgcn_s_sleep(1); \
    if ((++_sp & 255u) == 0u) { if (xb_ld(&(bar)[XB_TMO])) break; if (_sp > XB_SPIN_CAP) { atomicAdd(&(bar)[XB_TMO], 1u); break; } } } } while (0)

struct XcdBarrier {
    unsigned* bar; unsigned x;
    volatile LAS unsigned* st;
};

__device__ __forceinline__ XcdBarrier xcd_barrier_post(unsigned* bar, volatile LAS unsigned* st) {
    XcdBarrier b; b.bar = bar; b.x = xb_xcc_id(); b.st = st;
    if (threadIdx.x == 0) (void)xb_add(&bar[XB_XCNT(b.x)], 1u);
    return b;
}
__device__ __forceinline__ void xcd_barrier_complete(unsigned* bar, unsigned x, unsigned& nloc, unsigned& nx) {
    const unsigned G = gridDim.x * gridDim.y * gridDim.z;
    unsigned sum, cnt, mine, sp = 0u;
    for (;;) {
        sum = 0u; cnt = 0u; mine = 0u;
#pragma unroll
        for (unsigned j = 0; j < 16; ++j) { const unsigned c = xb_ld(&bar[XB_XCNT(j)]); sum += c; cnt += (c > 0u) ? 1u : 0u; mine = (j == x) ? c : mine; }
        if (sum == G) break;
        __builtin_amdgcn_s_sleep(1);
        if ((++sp & 255u) == 0u) { if (xb_ld(&bar[XB_TMO])) break; if (sp > XB_SPIN_CAP) { atomicAdd(&bar[XB_TMO], 1u); break; } }
    }
    nloc = mine > 0u ? mine : 1u; nx = cnt > 0u ? cnt : 1u;
}

__device__ __forceinline__ void xcd_barrier(const XcdBarrier& b) {
    asm volatile("s_waitcnt vmcnt(0)" ::: "memory");
    __syncthreads();
    if (threadIdx.x == 0) {
        unsigned* bar = b.bar;
        __builtin_amdgcn_s_waitcnt(0);
        unsigned nloc = b.st[0], nx = b.st[1];
        if (nloc == 0u) { xcd_barrier_complete(bar, b.x, nloc, nx); b.st[0] = nloc; b.st[1] = nx; }
        const unsigned old = xb_add(&bar[XB_XSUB(b.x)], 1u);
        const unsigned gen = old / nloc;
        if (old + 1u == (gen + 1u) * nloc) {
            __builtin_amdgcn_fence(__ATOMIC_RELEASE, "agent");
            asm volatile("s_waitcnt vmcnt(0)" ::: "memory");
            const unsigned og = xb_add(&bar[XB_TOP], 1u);
            const unsigned tg = og / nx;
            if (og + 1u == (tg + 1u) * nx) xb_add(&bar[XB_TOPGEN], 1u);
            else XB_SPIN(xb_ld(&bar[XB_TOPGEN]) == tg, bar);
            __builtin_amdgcn_fence(__ATOMIC_ACQUIRE, "agent");
            xb_add(&bar[XB_XGEN(b.x)], 1u);
            asm volatile("s_waitcnt vmcnt(0)" ::: "memory");
        } else {
            XB_SPIN(xb_ld(&bar[XB_XGEN(b.x)]) == gen, bar);
            __builtin_amdgcn_fence(__ATOMIC_ACQUIRE, "agent");
            asm volatile("s_waitcnt vmcnt(0)" ::: "memory");
        }
    }
    __syncthreads();
}

constexpr int NWAVES = 8;
constexpr int D = 1024, DFF = 2816, NFI = 2 * DFF, NIN = 3584, NMOD = 9, MODW = NMOD * D;
constexpr int NB_P = 8, SEQ = 8192, NB_S = 8, DSEQ = 32, PAST = 4096, DEPTH = 2;
constexpr int MP = NB_P * SEQ, MS = NB_S * DSEQ, MT = MP + MS;
constexpr int NHEAD = 4, HD = 128, RET = 512, CONVD = 512;
constexpr float EPS = 1e-6f;
constexpr size_t OFF_Y = 0, OFF_SRP = (size_t)MT * D, SZ_SR = (size_t)DEPTH * 8 * NHEAD * HD * HD, OFF_SCP = OFF_SRP + SZ_SR, SZ_SC = (size_t)DEPTH * 8 * 2 * CONVD,
                 OFF_SRS = OFF_SCP + SZ_SC, OFF_SCS = OFF_SRS + SZ_SR;
constexpr size_t MiB = 1u << 20;
constexpr size_t WS_CTL = 0, CTL_ZERO_BYTES = 64 * 1024;
constexpr size_t WS_MOD = 1 * MiB;
constexpr size_t WS_ROPE = 3 * MiB;
constexpr size_t WS_W = 8 * MiB;
constexpr size_t W_1I = 0, W_1O = 11 * MiB, W_IN = 17 * MiB, W_OUT = 24 * MiB, W_2I = 26 * MiB, W_2O = 37 * MiB, W_LAYER = 43 * MiB;
constexpr size_t WS_T = 96 * MiB;
constexpr size_t WS_H = 128 * MiB;
constexpr size_t WS_BIG = 260 * MiB;
constexpr size_t SZ_M512 = (size_t)MT * 512 * 2;
constexpr size_t WS_BIAS = 94 * MiB;
constexpr size_t BIAS_LAYER = (size_t)16 * (2 * NFI + NIN);
constexpr size_t WS_SS = 646 * MiB;
constexpr size_t WS_RS = 651 * MiB;
constexpr size_t WS_MIX = 652 * MiB;
constexpr size_t WS_PART = 784 * MiB;
constexpr size_t WS_XB = 800 * MiB;
constexpr size_t WS_END = WS_XB + (size_t)MT * D * 2;
static_assert(WS_PART + (size_t)11 * MS * D * 4 <= WS_XB, "ws map 3");
static_assert(WS_MIX + (size_t)MT * D * 2 <= WS_PART, "ws map 2");
static_assert(WS_BIG + 6 * SZ_M512 <= WS_SS && WS_SS + (size_t)MT * 64 <= WS_MIX && WS_W + 2 * W_LAYER <= WS_BIAS && WS_BIAS + 2 * BIAS_LAYER * 4 <= WS_T, "ws map");
static_assert((size_t)MT * DFF * 2 <= 6 * SZ_M512, "overlay");
constexpr int CW_BAR = 4096;
constexpr int RING_BYTES = 131072, LDSCTL_OFF = RING_BYTES, MISC_OFF = LDSCTL_OFF + 320, LDS_BYTES = 147456;
constexpr int TAB_OFF = RING_BYTES + 1024, TAB_BYTES = 2048;

typedef unsigned u32x2 __attribute__((ext_vector_type(2)));
typedef short s16x4 __attribute__((ext_vector_type(4)));
typedef float f32x2s __attribute__((ext_vector_type(2)));
typedef LAS unsigned char* ldsp;

struct Frame { ldsp lds; int tid, lane, wave, vcu, G; };

__device__ __forceinline__ float wave_sum(float v) {
#pragma unroll
    for (int o = 1; o < 64; o <<= 1) v += __shfl_xor(v, o);
    return v;
}
__device__ __forceinline__ float fexp2(float x) { return __builtin_amdgcn_exp2f(x); }
__device__ __forceinline__ float silu_f(float x) { return x * __builtin_amdgcn_rcpf(1.0f + fexp2(-1.4426950408889634f * x)); }
__device__ __forceinline__ float bf_lo(unsigned w) { return __builtin_bit_cast(float, w << 16); }
__device__ __forceinline__ float bf_hi(unsigned w) { return __builtin_bit_cast(float, w & 0xffff0000u); }
__device__ __forceinline__ unsigned cvtpk(float lo, float hi) { return pg8::cvt_pk_bf16(lo, hi); }

__device__ __forceinline__ int src_col(int type, int n) {
    if (type == 0) return n;
    const int pn = n >> 8, bj = (n >> 7) & 1, t = n & 127;
    if (type == 1) return bj * DFF + (pn << 7) + t;
    if (pn < 4) { const int base = (pn < 2) ? 0 : 512; return base + (2 * (pn & 1) + (t >> 6)) * 128 + 64 * bj + (t & 63); }
    if (pn < 8) return n;
    if (pn < 12) return 2560 + bj * 512 + ((pn - 8) << 7) + t;
    return 2048 + (n - 3072);
}
__device__ __forceinline__ void p0_transpose_item(const float* W, int K, int N, bf16* WT, int type, LAS float* scr, int item, int lane) {
    const int nblk = N / 32, kb = item / nblk, nb = item % nblk, k0 = 64 * kb, n0 = 32 * nb;
    const int sc = src_col(type, n0 + (lane & 31));
    float tv[32];
#pragma unroll
    for (int i = 0; i < 32; ++i) tv[i] = W[(size_t)(k0 + 2 * i + (lane >> 5)) * N + sc];
#pragma unroll
    for (int i = 0; i < 32; ++i) scr[(2 * i + (lane >> 5)) * 33 + (lane & 31)] = tv[i];
    LDS_WAIT(); asm volatile("" ::: "memory");
    const int c = lane & 7;
#pragma unroll
    for (int j = 0; j < 4; ++j) { const int n = (lane >> 3) + 8 * j; const LAS float* s = scr + (8 * c) * 33 + n;
        v4u o; o.x = pk2(s[0 * 33], s[1 * 33]); o.y = pk2(s[2 * 33], s[3 * 33]); o.z = pk2(s[4 * 33], s[5 * 33]); o.w = pk2(s[6 * 33], s[7 * 33]);
        *(GAS v4u*)(WT + (size_t)(n0 + n) * K + k0 + 8 * c) = o; }
    LDS_WAIT(); asm volatile("" ::: "memory");
}

struct Args { const float* in[21]; float* out; unsigned char* ws; int ph_lo, ph_hi; };
__device__ __forceinline__ void gemv16_item(const Frame& F, LAS float* sc, LAS float* red, const float* wcol, int ldw, const float* addv, float* out, int ldo) {
    float acc[16];
#pragma unroll
    for (int bb = 0; bb < 16; ++bb) acc[bb] = 0.f;
    const int k0 = F.wave * 128;
    for (int kb = 0; kb < 128; kb += 32) {
    float wvv[32];
#pragma unroll
    for (int q = 0; q < 32; ++q) wvv[q] = __builtin_nontemporal_load(wcol + (size_t)(k0 + kb + q) * ldw);
#pragma unroll
    for (int q = 0; q < 32; ++q) {
        const int k = kb + q; const float wv = wvv[q];
        const LAS f32x4* s4 = (const LAS f32x4*)(sc + (k0 + k) * 16);
        const f32x4 s0 = s4[0], s1 = s4[1], s2 = s4[2], s3 = s4[3];
        acc[0] += s0.x * wv; acc[1] += s0.y * wv; acc[2] += s0.z * wv; acc[3] += s0.w * wv;
        acc[4] += s1.x * wv; acc[5] += s1.y * wv; acc[6] += s1.z * wv; acc[7] += s1.w * wv;
        acc[8] += s2.x * wv; acc[9] += s2.y * wv; acc[10] += s2.z * wv; acc[11] += s2.w * wv;
        acc[12] += s3.x * wv; acc[13] += s3.y * wv; acc[14] += s3.z * wv; acc[15] += s3.w * wv;
    }
    }
#pragma unroll
    for (int bb = 0; bb < 16; ++bb) red[(F.wave * 16 + bb) * 64 + F.lane] = acc[bb];
    __syncthreads();
    for (int o = F.tid; o < 16 * 64; o += 512) { const int bb = o >> 6, c = o & 63; float s = addv ? addv[c] : 0.f;
#pragma unroll
        for (int w8 = 0; w8 < 8; ++w8) s += red[(w8 * 16 + bb) * 64 + c];
        out[(size_t)bb * ldo + c] = s; }
    __syncthreads();
}

__device__ __forceinline__ void p0_prologue(const Frame& F, const Args& a) {
    {
        LAS float* scr = (LAS float*)(F.lds + F.wave * 16384);
        const int gw = F.vcu * NWAVES + F.wave, NGW = F.G * NWAVES;
        constexpr int I_FI = (D / 64) * (NFI / 32), I_FO = (DFF / 64) * (D / 32), I_IN = (D / 64) * (NIN / 32), I_OUT = (D / 64) * (D / 32);
        constexpr int I_LAYER = 2 * I_FI + 2 * I_FO + I_IN + I_OUT;
        for (int it = gw; it < DEPTH * I_LAYER; it += NGW) {
            const int l = it / I_LAYER; int r = it % I_LAYER;
            bf16* wl = (bf16*)(a.ws + WS_W + (size_t)l * W_LAYER);
            if (r < I_FI) { p0_transpose_item(a.in[9] + (size_t)l * D * NFI, D, NFI, (bf16*)((unsigned char*)wl + W_1I), 1, scr, r, F.lane); continue; } r -= I_FI;
            if (r < I_FO) { p0_transpose_item(a.in[10] + (size_t)l * DFF * D, DFF, D, (bf16*)((unsigned char*)wl + W_1O), 0, scr, r, F.lane); continue; } r -= I_FO;
            if (r < I_IN) { p0_transpose_item(a.in[12] + (size_t)l * D * NIN, D, NIN, (bf16*)((unsigned char*)wl + W_IN), 2, scr, r, F.lane); continue; } r -= I_IN;
            if (r < I_OUT) { p0_transpose_item(a.in[16] + (size_t)l * D * D, D, D, (bf16*)((unsigned char*)wl + W_OUT), 0, scr, r, F.lane); continue; } r -= I_OUT;
            if (r < I_FI) { p0_transpose_item(a.in[18] + (size_t)l * D * NFI, D, NFI, (bf16*)((unsigned char*)wl + W_2I), 1, scr, r, F.lane); continue; } r -= I_FI;
            p0_transpose_item(a.in[19] + (size_t)l * DFF * D, DFF, D, (bf16*)((unsigned char*)wl + W_2O), 0, scr, r, F.lane);
        }
    }
    {
        float* rc = (float*)(a.ws + WS_ROPE); float* rs = rc + 8192 * 64;
        for (int idx = F.vcu * 512 + F.tid; idx < 8192 * 64; idx += F.G * 512) {
            const int pos = idx >> 6, i = idx & 63;
            double inv = 1.0; for (int q = 0; q < i; ++q) inv *= 0.8659643233600653;
            const double ang = (double)pos * inv;
            const double rev = ang * 0.15915494309189535; const double fr = rev - __builtin_rint(rev);
            const float r = (float)(fr * 6.283185307179586);
            rc[idx] = __cosf(r); rs[idx] = __sinf(r);
        }
    }
    __syncthreads();
    {
        LAS float* sc = (LAS float*)F.lds;
        LAS float* red = (LAS float*)(F.lds + 65536);
#pragma unroll 8
        for (int e = F.tid; e < 16 * D; e += 512) { const int bb = e >> 10, k = e & 1023; const float v = (bb < 8) ? a.in[2][bb * D + k] : a.in[3][(bb - 8) * D + k]; sc[k * 16 + bb] = silu_f(v); }
        __syncthreads();
        float* mod = (float*)(a.ws + WS_MOD);
        constexpr int NITEM = DEPTH * (MODW / 64);
        for (int it = F.vcu; it < NITEM; it += F.G) {
            const int l = it / (MODW / 64), n0 = (it % (MODW / 64)) * 64;
            gemv16_item(F, sc, red, a.in[6] + (size_t)l * D * MODW + n0 + F.lane, MODW, a.in[7] + (size_t)l * MODW + n0, mod + (size_t)l * 16 * MODW + n0, MODW);
        }
    }
}

__device__ __forceinline__ void prepass_phase(const Frame& F, const Args& a) {
    LAS float* sc = (LAS float*)F.lds; LAS float* red = (LAS float*)(F.lds + 65536);
    const float* mod = (const float*)(a.ws + WS_MOD); float* bias = (float*)(a.ws + WS_BIAS);
    constexpr int I1 = NFI / 64, I2 = NIN / 64, IL = 2 * I1 + I2;
    for (int it = F.vcu; it < DEPTH * IL; it += F.G) {
        const int l = it / IL; int r = it % IL; int mat = 0; if (r >= I1) { r -= I1; mat = 1; if (r >= I2) { r -= I2; mat = 2; } }
        const int N = (mat == 1) ? NIN : NFI, type = (mat == 1) ? 2 : 1, n0 = r * 64;
        const float* W = (mat == 0) ? a.in[9] + (size_t)l * D * NFI : (mat == 1) ? a.in[12] + (size_t)l * D * NIN : a.in[18] + (size_t)l * D * NFI;
        const float* shv = mod + (size_t)l * 16 * MODW + (size_t)(3 * mat) * D;
#pragma unroll 8
        for (int e = F.tid; e < 16 * D; e += 512) { const int bb = e >> 10, k = e & 1023; sc[k * 16 + bb] = shv[(size_t)bb * MODW + k]; }
        __syncthreads();
        float* out = bias + (size_t)l * BIAS_LAYER + (mat == 0 ? 0 : mat == 1 ? (size_t)16 * NFI : (size_t)16 * (NFI + NIN)) + n0;
        gemv16_item(F, sc, red, W + src_col(type, n0 + F.lane), N, nullptr, out, N);
    }
    const int gw = F.vcu * NWAVES + F.wave, NGW = F.G * NWAVES;
    bf16* H = (bf16*)(a.ws + WS_H); float* SS = (float*)(a.ws + WS_SS); const float* g = a.in[8]; bf16* XB = (bf16*)(a.ws + WS_XB);
    constexpr int R = 4;
    for (int row0 = gw * R; row0 < MT; row0 += NGW * R) {
        f32x4 v[R][4];
#pragma unroll
        for (int r = 0; r < R; ++r) { const int row = row0 + r; const float* xr = (row < MP) ? a.in[0] + (size_t)row * D : a.in[1] + (size_t)(row - MP) * D;
            const GAS f32x4* x4 = (const GAS f32x4*)xr + F.lane;
#pragma unroll
            for (int j = 0; j < 4; ++j) v[r][j] = __builtin_nontemporal_load(x4 + 64 * j); }
#pragma unroll
        for (int r = 0; r < R; ++r) {
            const int row = row0 + r; const int bb = (row < MP) ? (row >> 13) : 8 + ((row - MP) >> 5);
            float s = 0.f;
#pragma unroll
            for (int j = 0; j < 4; ++j) s += (v[r][j].x * v[r][j].x + v[r][j].y * v[r][j].y) + (v[r][j].z * v[r][j].z + v[r][j].w * v[r][j].w);
            s = wave_sum(s);
            if (F.lane == 0) ((float*)(a.ws + WS_RS))[row] = __builtin_amdgcn_rsqf(s * (1.0f / D) + EPS);
            const float* scv = mod + (size_t)bb * MODW + D;
            GAS u32x2* o8 = (GAS u32x2*)(H + (size_t)row * D) + F.lane; GAS u32x2* x8 = (GAS u32x2*)(XB + (size_t)row * D) + F.lane;
#pragma unroll
            for (int j = 0; j < 4; ++j) {
                const int c = 4 * F.lane + 256 * j;
                { u32x2 xo; xo.x = cvtpk(v[r][j].x, v[r][j].y); xo.y = cvtpk(v[r][j].z, v[r][j].w); x8[64 * j] = xo; }
                const f32x4 gv = *(const f32x4*)(g + c), sv = *(const f32x4*)(scv + c);
                const f32x4 y = v[r][j] * (gv * (sv + 1.0f));
                u32x2 o; o.x = cvtpk(y.x, y.y); o.y = cvtpk(y.z, y.w); o8[64 * j] = o;
            }
        }
    }
}
__device__ __forceinline__ float row_rstd(const float* SS, int row) {
    const f32x4* p = (const f32x4*)(SS + (size_t)row * 16); const f32x4 a = p[0], b = p[1], c = p[2], d = p[3];
    const float s = ((a.x + a.y) + (a.z + a.w)) + ((b.x + b.y) + (b.z + b.w)) + ((c.x + c.y) + (c.z + c.w)) + ((d.x + d.y) + (d.z + d.w));
    return __builtin_amdgcn_rsqf(s * (1.0f / D) + EPS);
}
__device__ __forceinline__ void rs_phase(const Frame& F, const float* SS, float* RS, int nrows) {
    for (int row = F.vcu * 512 + F.tid; row < nrows; row += F.G * 512) RS[row] = row_rstd(SS, row);
}
__device__ __forceinline__ void final_norm_phase(const Frame& F, const bf16* XB, float* Y, const float* g) {
    const int gw = F.vcu * NWAVES + F.wave, NGW = F.G * NWAVES;
    constexpr int R = 4;
    f32x4 gv[4];
#pragma unroll
    for (int j = 0; j < 4; ++j) gv[j] = *(const f32x4*)(g + 4 * F.lane + 256 * j);
    for (int row0 = gw * R; row0 < MP; row0 += NGW * R) {
        u32x2 w[R][4];
#pragma unroll
        for (int r = 0; r < R; ++r) { const GAS u32x2* x8 = (const GAS u32x2*)(XB + (size_t)(row0 + r) * D) + F.lane;
#pragma unroll
            for (int j = 0; j < 4; ++j) w[r][j] = __builtin_nontemporal_load(x8 + 64 * j); }
#pragma unroll
        for (int r = 0; r < R; ++r) {
            f32x4 v[4]; float s = 0.f;
#pragma unroll
            for (int j = 0; j < 4; ++j) { v[j] = (f32x4){bf_lo(w[r][j].x), bf_hi(w[r][j].x), bf_lo(w[r][j].y), bf_hi(w[r][j].y)}; s += (v[j].x * v[j].x + v[j].y * v[j].y) + (v[j].z * v[j].z + v[j].w * v[j].w); }
            const float rstd = __builtin_amdgcn_rsqf(wave_sum(s) * (1.0f / D) + EPS);
            GAS f32x4* y4 = (GAS f32x4*)(Y + (size_t)(row0 + r) * D) + F.lane;
#pragma unroll
            for (int j = 0; j < 4; ++j) __builtin_nontemporal_store((v[j] * rstd) * gv[j], y4 + 64 * j);
        }
    }
}

template <class T> __device__ __forceinline__ T* uni_ptr(T* p) {
    const unsigned long long v = (unsigned long long)p; const unsigned lo = __builtin_amdgcn_readfirstlane((unsigned)v), hi = __builtin_amdgcn_readfirstlane((unsigned)(v >> 32));
    return (T*)(((unsigned long long)hi << 32) | lo);
}
using pg8::Unit;
struct EpiFFN {
    static constexpr bool PERM = true, AFTER_DRAIN = false;
    static constexpr bool HAS_TAB = true;
    ldsp lds; int ldb;
    __device__ __forceinline__ int tab_off(int par) const { return TAB_OFF + par * TAB_BYTES; }
    __device__ __forceinline__ float pre_load(const Unit& nx, int wid, int lane) const {
        if (nx.pm >= 256) return 0.f;
        const int idx = wid * 32 + (lane & 31);
        return (lane < 32) ? RS[nx.pm * 256 + idx] : bias[(size_t)(nx.pm >> 5) * ldb + nx.pn * 256 + idx];
    }
    __device__ __forceinline__ void pre_store(float v, const Unit& nx, int wid, int lane) const {
        if (nx.pm >= 256) return;
        *(LAS float*)(lds + nx.tab + (lane >= 32 ? 1024 : 0) + (wid * 32 + (lane & 31)) * 4) = v;
    }
    bf16* ACT; const float* RS; const float* bias;
    __device__ __forceinline__ void operator()(const f32x4 (&acc)[2][2][4][2], const Unit& u, int wr, int wc, int fr, int fq) const {
        asm volatile("" : "+v"(fr), "+v"(fq));
        const int lrow0 = wr * 64 + fr, col0 = u.pn * 128 + wc * 32 + 8 * fq, bc0 = u.pn * 256 + wc * 32 + 8 * fq;
        const bool smp = u.pm >= 256;
        float rs[8]; f32x4 bg0, bg1, bu0, bu1;
        if (!smp) {
#pragma unroll
            for (int it = 0; it < 8; ++it) rs[it] = *(const LAS float*)(lds + u.tab + (lrow0 + (it >> 2) * 128 + (it & 3) * 16) * 4);
            const LAS f32x4* bl = (const LAS f32x4*)(lds + u.tab + 1024 + (wc * 32 + 8 * fq) * 4);
            bg0 = bl[0]; bg1 = bl[1]; bu0 = bl[32]; bu1 = bl[33];
        } else {
#pragma unroll
            for (int it = 0; it < 8; ++it) rs[it] = RS[u.pm * 256 + lrow0 + (it >> 2) * 128 + (it & 3) * 16];
            const float* bp = bias + (size_t)8 * NFI + bc0;
            bg0 = *(const f32x4*)(bp); bg1 = *(const f32x4*)(bp + 4); bu0 = *(const f32x4*)(bp + 128); bu1 = *(const f32x4*)(bp + 132);
        }
#pragma unroll
        for (int it = 0; it < 8; ++it) {
            const int ai = it >> 2, mm = it & 3, lrow = lrow0 + ai * 128 + mm * 16;
            if (smp) { const float* bq = bias + (size_t)(8 + (lrow >> 5)) * NFI + bc0; bg0 = *(const f32x4*)(bq); bg1 = *(const f32x4*)(bq + 4); bu0 = *(const f32x4*)(bq + 128); bu1 = *(const f32x4*)(bq + 132); }
            const f32x4 g0 = acc[ai][0][mm][0] * rs[it] + bg0, g1 = acc[ai][0][mm][1] * rs[it] + bg1, u0 = acc[ai][1][mm][0] * rs[it] + bu0, u1 = acc[ai][1][mm][1] * rs[it] + bu1;
            v4u w;
            w.x = cvtpk(silu_f(g0.x) * u0.x, silu_f(g0.y) * u0.y); w.y = cvtpk(silu_f(g0.z) * u0.z, silu_f(g0.w) * u0.w);
            w.z = cvtpk(silu_f(g1.x) * u1.x, silu_f(g1.y) * u1.y); w.w = cvtpk(silu_f(g1.z) * u1.z, silu_f(g1.w) * u1.w);
            *(GAS v4u*)(ACT + (size_t)(u.pm * 256 + lrow) * DFF + col0) = w;
        }
    }
};
struct EpiRes {
    static constexpr bool PERM = true, AFTER_DRAIN = false, HAS_TAB = false;
    const bf16* xP; bf16* X; const float* gate; int halfc;
    bf16* An; const float* gnext; const float* scn; float* SS; float* PART;
    __device__ __forceinline__ void operator()(const f32x4 (&acc)[2][2][4][2], const Unit& u, int wr, int wc, int fr, int fq) const {
        asm volatile("" : "+v"(fr), "+v"(fq));
        const int col0 = u.pn * 256 + wc * 32 + 8 * fq, lrow0 = wr * 64 + fr;
        if (u.pm >= 256) {
            float* pb = PART + ((size_t)(u.kt0 >> 2) * MS + lrow0) * D + col0;
#pragma unroll
            for (int it = 0; it < 8; ++it) { float* pr = pb + (size_t)((it >> 2) * 128 + (it & 3) * 16) * D;
#pragma unroll
                for (int q = 0; q < 4; ++q) *(f32x4*)(pr + (q >> 1) * 128 + (q & 1) * 4) = acc[it >> 2][q >> 1][it & 3][q & 1]; }
            return;
        }
        const float coef = halfc ? 0.5f : 1.0f;
        const bf16* xbase = xP + (size_t)(u.pm * 256 + lrow0) * D + col0;
        constexpr int PF = 3;
        f32x4 gv[4], gs[4]; v4u xr[PF + 1][2];
        { const int bb = u.pm >> 5; const float* gp = gate + (size_t)bb * MODW + col0; const float* sp = scn + (size_t)bb * MODW + col0;
#pragma unroll
          for (int q = 0; q < 4; ++q) { const int o = (q >> 1) * 128 + (q & 1) * 4; gv[q] = *(const f32x4*)(gp + o) * coef; gs[q] = *(const f32x4*)(gnext + col0 + o) * (*(const f32x4*)(sp + o) + 1.0f); } }
#pragma unroll
        for (int p = 0; p < PF; ++p) { const bf16* xq = xbase + (size_t)((p >> 2) * 128 + (p & 3) * 16) * D; xr[p][0] = *(const GAS v4u*)(xq); xr[p][1] = *(const GAS v4u*)(xq + 128); }
#pragma unroll
        for (int it = 0; it < 8; ++it) {
            const int ai = it >> 2, mm = it & 3, lrow = lrow0 + ai * 128 + mm * 16, row = u.pm * 256 + lrow;
            if (it + PF < 8) { const bf16* xq = xbase + (size_t)(((it + PF) >> 2) * 128 + ((it + PF) & 3) * 16) * D; xr[(it + PF) % (PF + 1)][0] = *(const GAS v4u*)(xq); xr[(it + PF) % (PF + 1)][1] = *(const GAS v4u*)(xq + 128); }
            bf16* xn = X + (size_t)row * D + col0; bf16* anp = An + (size_t)row * D + col0; float ssum = 0.f;
#pragma unroll
            for (int bj = 0; bj < 2; ++bj) {
                const v4u xo = xr[it % (PF + 1)][bj];
                const f32x4 x0 = (f32x4){bf_lo(xo.x), bf_hi(xo.x), bf_lo(xo.y), bf_hi(xo.y)} + gv[2 * bj] * acc[ai][bj][mm][0], x1 = (f32x4){bf_lo(xo.z), bf_hi(xo.z), bf_lo(xo.w), bf_hi(xo.w)} + gv[2 * bj + 1] * acc[ai][bj][mm][1];
                v4u wx; wx.x = cvtpk(x0.x, x0.y); wx.y = cvtpk(x0.z, x0.w); wx.z = cvtpk(x1.x, x1.y); wx.w = cvtpk(x1.z, x1.w); *(GAS v4u*)(xn + bj * 128) = wx;
                ssum += ((x0.x * x0.x + x0.y * x0.y) + (x0.z * x0.z + x0.w * x0.w)) + ((x1.x * x1.x + x1.y * x1.y) + (x1.z * x1.z + x1.w * x1.w));
                const f32x4 y0 = x0 * gs[2 * bj], y1 = x1 * gs[2 * bj + 1];
                v4u w; w.x = cvtpk(y0.x, y0.y); w.y = cvtpk(y0.z, y0.w); w.z = cvtpk(y1.x, y1.y); w.w = cvtpk(y1.z, y1.w); *(GAS v4u*)(anp + bj * 128) = w; }
            ssum += __shfl_xor(ssum, 16); ssum += __shfl_xor(ssum, 32);
            if (fq == 0) SS[(size_t)row * 16 + u.pn * 4 + wc] = ssum;
        }
    }
};
struct ResOrder {
    pg8::StaticOrder so; int nsl, nr, nn, nks, cs;
    __device__ void init(int K, int N, int nsl_, int G_, int c_) { so.init(MP, N, G_, c_); so.ntf = K / 64; nsl = nsl_; nks = K / 64 / nsl_; nn = N / 256; nr = (so.nwg + G_ - 1) / G_; cs = c_; }
    __device__ bool next(int i, Unit& u) const {
        if (i < nr) { if (so.next(i, u)) return true; }
        const int j = (i - nr) * so.G + cs; if (i < nr || j >= nn * nsl) return false;
        u.pm = 256; u.pn = j % nn; u.kt0 = (j / nn) * nks; u.nkt = nks; return true;
    }
    __device__ __forceinline__ void a_ready(const Unit&) const {}
    __device__ __forceinline__ void done(const Unit&) const {}
};
struct CombArgs { const float* PART; int nsl; const bf16* xoldS; bf16* XS; const float* gate; float coef; bf16* AnS; const float* gnext; const float* scn; float* RSs; };
__device__ __forceinline__ void sample_combine_row(const Frame& F, const CombArgs& C, int lr, f32x4 (&xw)[4], float& rstd) {
    const int bb = 8 + (lr >> 5); float ss = 0.f;
#pragma unroll
    for (int j = 0; j < 4; ++j) { const int c = 4 * F.lane + 256 * j;
        f32x4 pp[11];
#pragma unroll
        for (int sl = 0; sl < 11; ++sl) pp[sl] = (sl < C.nsl) ? *(const f32x4*)(C.PART + ((size_t)sl * MS + lr) * D + c) : (f32x4){0.f, 0.f, 0.f, 0.f};
        f32x4 s = pp[0];
#pragma unroll
        for (int sl = 1; sl < 11; ++sl) s += pp[sl];
        const u32x2 xo = *(const GAS u32x2*)(C.xoldS + (size_t)lr * D + c);
        xw[j] = (f32x4){bf_lo(xo.x), bf_hi(xo.x), bf_lo(xo.y), bf_hi(xo.y)} + (*(const f32x4*)(C.gate + (size_t)bb * MODW + c) * C.coef) * s;
        ss += (xw[j].x * xw[j].x + xw[j].y * xw[j].y) + (xw[j].z * xw[j].z + xw[j].w * xw[j].w); }
    rstd = __builtin_amdgcn_rsqf(wave_sum(ss) * (1.0f / D) + EPS);
}
__device__ __forceinline__ void sample_combine(const Frame& F, const CombArgs& C) {
    const int gw = F.vcu * NWAVES + F.wave, NGW = F.G * NWAVES;
    for (int lr = gw; lr < MS; lr += NGW) {
        f32x4 xw[4]; float rstd; sample_combine_row(F, C, lr, xw, rstd);
        const int bb = 8 + (lr >> 5);
#pragma unroll
        for (int j = 0; j < 4; ++j) { const int c = 4 * F.lane + 256 * j;
            { u32x2 wx; wx.x = cvtpk(xw[j].x, xw[j].y); wx.y = cvtpk(xw[j].z, xw[j].w); *(GAS u32x2*)(C.XS + (size_t)lr * D + c) = wx; }
            const f32x4 y = xw[j] * (*(const f32x4*)(C.gnext + c) * (*(const f32x4*)(C.scn + (size_t)bb * MODW + c) + 1.0f));
            u32x2 w; w.x = cvtpk(y.x, y.y); w.y = cvtpk(y.z, y.w); *(GAS u32x2*)(C.AnS + (size_t)lr * D + c) = w; }
        if (F.lane == 0) C.RSs[lr] = rstd;
    }
}
struct EpiMix {
    static constexpr bool PERM = true, AFTER_DRAIN = false;
    static constexpr bool HAS_TAB = true;
    ldsp lds; int ldb;
    __device__ __forceinline__ int tab_off(int par) const { return TAB_OFF + par * TAB_BYTES; }
    __device__ __forceinline__ float pre_load(const Unit& nx, int wid, int lane) const {
        if (nx.pm >= 256) return 0.f;
        const int idx = wid * 32 + (lane & 31);
        return (lane < 32) ? row_rstd(SSp, nx.pm * 256 + idx) : bias[(size_t)(nx.pm >> 5) * ldb + nx.pn * 256 + idx];
    }
    __device__ __forceinline__ void pre_store(float v, const Unit& nx, int wid, int lane) const {
        if (nx.pm >= 256) return;
        *(LAS float*)(lds + nx.tab + (lane >= 32 ? 1024 : 0) + (wid * 32 + (lane & 31)) * 4) = v;
    }
    bf16* base6; const float* rcos; const float* rsin; float* scP; float* scS; const float* RS; const float* bias; const float* SSp;
    __device__ __forceinline__ void operator()(const f32x4 (&acc)[2][2][4][2], const Unit& u, int wr, int wc, int fr, int fq) const {
        asm volatile("" : "+v"(fr), "+v"(fq));
        const int pn = u.pn, t0 = wc * 32 + 8 * fq;
        const bool smp = u.pm >= 256;
        float rsv[8]; f32x4 B00, B01, B10, B11;
        if (!smp) {
#pragma unroll
            for (int it = 0; it < 8; ++it) rsv[it] = *(const LAS float*)(lds + u.tab + (wr * 64 + fr + (it >> 2) * 128 + (it & 3) * 16) * 4);
            const LAS f32x4* bl = (const LAS f32x4*)(lds + u.tab + 1024 + t0 * 4);
            B00 = bl[0]; B01 = bl[1]; B10 = bl[32]; B11 = bl[33];
        } else {
#pragma unroll
            for (int it = 0; it < 8; ++it) rsv[it] = RS[u.pm * 256 + wr * 64 + fr + (it >> 2) * 128 + (it & 3) * 16];
            const float* bp0 = bias + (size_t)8 * NIN + pn * 256 + t0;
            B00 = *(const f32x4*)(bp0); B01 = *(const f32x4*)(bp0 + 4); B10 = *(const f32x4*)(bp0 + 128); B11 = *(const f32x4*)(bp0 + 132);
        }
#pragma unroll
        for (int ai = 0; ai < 2; ++ai)
#pragma unroll
            for (int m = 0; m < 4; ++m) {
                const int lrow = ai * 128 + wr * 64 + m * 16 + fr, row = u.pm * 256 + lrow;
                const int pos = (u.pm < 256) ? (row & (SEQ - 1)) : PAST + (lrow & 31);
                if (smp) { const float* bp = bias + (size_t)(8 + (lrow >> 5)) * NIN + pn * 256 + t0; B00 = *(const f32x4*)(bp); B01 = *(const f32x4*)(bp + 4); B10 = *(const f32x4*)(bp + 128); B11 = *(const f32x4*)(bp + 132); }
                const float rs = rsv[ai * 4 + m];
                const f32x4 A00 = acc[ai][0][m][0] * rs + B00, A01 = acc[ai][0][m][1] * rs + B01, A10 = acc[ai][1][m][0] * rs + B10, A11 = acc[ai][1][m][1] * rs + B11;
                if (pn < 4) {
                    const int head = 2 * (pn & 1) + (wc >> 1), dd0 = (wc & 1) * 32 + 8 * fq;
                    const float sclk = (pn < 2) ? 1.0f : 0.08838834764831845f;
                    const f32x4 c0 = *(const f32x4*)(rcos + pos * 64 + dd0), c1 = *(const f32x4*)(rcos + pos * 64 + dd0 + 4);
                    const f32x4 s0 = *(const f32x4*)(rsin + pos * 64 + dd0), s1 = *(const f32x4*)(rsin + pos * 64 + dd0 + 4);
                    const f32x4 a0 = A00, a1 = A01, b0 = A10, b1 = A11;
                    const f32x4 o10 = (a0 * c0 - b0 * s0) * sclk, o11 = (a1 * c1 - b1 * s1) * sclk, o20 = (a0 * s0 + b0 * c0) * sclk, o21 = (a1 * s1 + b1 * c1) * sclk;
                    bf16* dst = base6 + (size_t)(pn >> 1) * (SZ_M512 / 2) + (size_t)row * RET + head * HD + dd0;
                    v4u w1, w2; w1.x = cvtpk(o10.x, o10.y); w1.y = cvtpk(o10.z, o10.w); w1.z = cvtpk(o11.x, o11.y); w1.w = cvtpk(o11.z, o11.w);
                    w2.x = cvtpk(o20.x, o20.y); w2.y = cvtpk(o20.z, o20.w); w2.z = cvtpk(o21.x, o21.y); w2.w = cvtpk(o21.z, o21.w);
                    *(GAS v4u*)dst = w1; *(GAS v4u*)(dst + 64) = w2;
                } else if (pn < 8 || pn >= 12) {
                    const int bi = (pn < 8) ? (pn >> 1) : 4;
                    bf16* dst = base6 + (size_t)bi * (SZ_M512 / 2) + (size_t)row * 512 + (pn & 1) * 256 + t0;
#pragma unroll
                    for (int bj = 0; bj < 2; ++bj) { const f32x4 a0 = bj ? A10 : A00, a1 = bj ? A11 : A01;
                        v4u w; w.x = cvtpk(a0.x, a0.y); w.y = cvtpk(a0.z, a0.w); w.z = cvtpk(a1.x, a1.y); w.w = cvtpk(a1.z, a1.w);
                        *(GAS v4u*)(dst + bj * 128) = w; }
                } else {
                    const int ch0 = (pn - 8) * 128 + t0;
                    const f32x4 p0 = A00 * A10, p1 = A01 * A11;
                    v4u w; w.x = cvtpk(p0.x, p0.y); w.y = cvtpk(p0.z, p0.w); w.z = cvtpk(p1.x, p1.y); w.w = cvtpk(p1.z, p1.w);
                    *(GAS v4u*)(base6 + (size_t)5 * (SZ_M512 / 2) + (size_t)row * 512 + ch0) = w;
                    if (u.pm < 256) { if (pos >= SEQ - 2) { float* d = scP + ((size_t)(row >> 13) * 2 + (pos - (SEQ - 2))) * CONVD + ch0; *(f32x4*)d = p0; *(f32x4*)(d + 4) = p1; } }
                    else { const int lp = lrow & 31; if (lp >= DSEQ - 2) { float* d = scS + ((size_t)(lrow >> 5) * 2 + (lp - (DSEQ - 2))) * CONVD + ch0; *(f32x4*)d = p0; *(f32x4*)(d + 4) = p1; } }
                }
                asm volatile("" ::: "memory");
            }
    }
};

struct RetArgs { const bf16 *Q, *K, *V, *Gt; bf16* MIX; float* T; const float* gn; const float* Sin; float* SoutP; float* SoutS; };
constexpr int RL_Q = 0, RL_K = 17408, RL_KD = 34816, RL_V = 52224, RL_P = 69632, RL_ST = 78848;
__device__ __forceinline__ s16x4 tr_read(ldsp p) { typedef short v4i16_t __attribute__((ext_vector_type(4))); return __builtin_bit_cast(s16x4, __builtin_amdgcn_ds_read_tr16_b64_v4i16((LAS v4i16_t*)p)); }
__device__ __forceinline__ bf16x8 cat4(s16x4 lo, s16x4 hi) { bf16x8 r; r[0] = lo[0]; r[1] = lo[1]; r[2] = lo[2]; r[3] = lo[3]; r[4] = hi[0]; r[5] = hi[1]; r[6] = hi[2]; r[7] = hi[3]; return r; }
__device__ __forceinline__ v4u scale8(v4u k, float s) {
    v4u r; r.x = cvtpk(bf_lo(k.x) * s, bf_hi(k.x) * s); r.y = cvtpk(bf_lo(k.y) * s, bf_hi(k.y) * s); r.z = cvtpk(bf_lo(k.z) * s, bf_hi(k.z) * s); r.w = cvtpk(bf_lo(k.w) * s, bf_hi(k.w) * s); return r; }

template <int L, bool FULL>
__device__ __forceinline__ void ret_item(const Frame& F, const RetArgs& R, int row0, int h, int nch, f32x4 (&S)[8], float lg2) {
    constexpr int NB = L / 16, KS = L / 32, NLD = L / 32;
    const int wave = F.wave, lr = F.tid >> 4, c16 = F.tid & 15;
    const ldsp lds = F.lds;
    v4u rq[NLD], rk[NLD], rv[NLD];
#define RET_GLOAD(ch) do { _Pragma("unroll") for (int i = 0; i < NLD; ++i) { const size_t off = (size_t)(row0 + (ch) * L + lr + 32 * i) * RET + h * HD + c16 * 8; \
        if (FULL) rq[i] = *(const GAS v4u*)(R.Q + off); rk[i] = *(const GAS v4u*)(R.K + off); rv[i] = *(const GAS v4u*)(R.V + off); } } while (0)
    RET_GLOAD(0);
    const float gL = fexp2(lg2 * (float)L);
    for (int ch = 0; ch < nch; ++ch) {
        int lane = F.lane; asm volatile("" : "+v"(lane));
        const int fr = lane & 15, fq = lane >> 4;
        const int b272 = fr * 272 + fq * 16, bq8 = fr * 272 + fq * 8, btr = (fq * 8 + (fr >> 2)) * 272 + (fr & 3) * 8, b144w = fr * 144 + fq * 8, b144r = fr * 144 + fq * 16, bst = fr * 64;
        const int okd = FULL ? RL_KD : ((ch & 1) ? RL_Q : RL_KD), ov = FULL ? RL_V : ((ch & 1) ? RL_K : RL_V);
        {   int tl = F.tid; asm volatile("" : "+v"(tl)); const int ow = (tl >> 4) * 272 + (tl & 15) * 16;
#pragma unroll
            for (int i = 0; i < NLD; ++i) { const int j = (tl >> 4) + 32 * i; const int o = ow + i * 32 * 272;
                if (FULL) { *(LAS v4u*)(lds + RL_Q + o) = rq[i]; *(LAS v4u*)(lds + RL_K + o) = rk[i]; }
                *(LAS v4u*)(lds + okd + o) = scale8(rk[i], fexp2(lg2 * (float)(L - 1 - j)));
                *(LAS v4u*)(lds + ov + o) = rv[i]; } }
        LDS_WAIT(); __syncthreads();
        if (ch + 1 < nch) RET_GLOAD(ch + 1);
        f32x4 o[NB];
        bf16x8 vf[KS];
        u32x2 gpre[NB];
        if (FULL) {
#pragma unroll
            for (int ib = 0; ib < NB; ++ib) gpre[ib] = *(const GAS u32x2*)(R.Gt + (size_t)(row0 + ch * L + ib * 16 + fr) * RET + h * HD + wave * 16 + fq * 4); }
        if (FULL) {
            for (int blk = wave; blk < NB * NB; blk += 8) {
                const int ib = blk / NB, jb = blk % NB;
                f32x4 acc = {0.f, 0.f, 0.f, 0.f};
                const ldsp kp = lds + RL_K + jb * (16 * 272) + b272, qp = lds + RL_Q + ib * (16 * 272) + b272;
#pragma unroll
                for (int s = 0; s < 4; ++s) {
                    const bf16x8 ka = *(const LAS bf16x8*)(kp + s * 64);
                    const bf16x8 qb = *(const LAS bf16x8*)(qp + s * 64);
                    acc = __builtin_amdgcn_mfma_f32_16x16x32_bf16(ka, qb, acc, 0, 0, 0);
                }
                const int dij = (ib - jb) * 16 + fr - fq * 4;
                float p[4];
#pragma unroll
                for (int t = 0; t < 4; ++t) { const int dj = dij - t; p[t] = acc[t] * fexp2(lg2 * (float)(dj < 0 ? -dj : dj)); }
                u32x2 w; w.x = cvtpk(p[0], p[1]); w.y = cvtpk(p[2], p[3]);
                *(LAS u32x2*)(lds + RL_P + ib * (16 * 144) + jb * 32 + b144w) = w;
            }
            LDS_WAIT(); __syncthreads();
        }
        __builtin_amdgcn_sched_barrier(0);
        {   const ldsp p = lds + ov + wave * 32 + btr;
#pragma unroll
            for (int ks = 0; ks < KS; ++ks) vf[ks] = cat4(tr_read(p + ks * (32 * 272)), tr_read(p + ks * (32 * 272) + 4 * 272)); }
        if (FULL) {
            __builtin_amdgcn_sched_barrier(0);
            bf16x8 sf[4];
#pragma unroll
            for (int s = 0; s < 4; ++s) { v4u w; w.x = cvtpk(S[2 * s][0], S[2 * s][1]); w.y = cvtpk(S[2 * s][2], S[2 * s][3]); w.z = cvtpk(S[2 * s + 1][0], S[2 * s + 1][1]); w.w = cvtpk(S[2 * s + 1][2], S[2 * s + 1][3]);
                sf[s] = __builtin_bit_cast(bf16x8, w); }
            const float cdl = lg2 * (float)(fr + 1);
#pragma unroll
            for (int ib = 0; ib < NB; ++ib) {
                f32x4 acc = {0.f, 0.f, 0.f, 0.f};
                const ldsp qrow = lds + RL_Q + ib * (16 * 272) + bq8;
#pragma unroll
                for (int s = 0; s < 4; ++s) {
                    const u32x2 lo = *(const LAS u32x2*)(qrow + (2 * s) * 32), hi = *(const LAS u32x2*)(qrow + (2 * s + 1) * 32);
                    v4u w; w.x = lo.x; w.y = lo.y; w.z = hi.x; w.w = hi.y;
                    acc = __builtin_amdgcn_mfma_f32_16x16x32_bf16(sf[s], __builtin_bit_cast(bf16x8, w), acc, 0, 0, 0);
                }
                acc = acc * fexp2(cdl + lg2 * (float)(ib * 16));
                const ldsp pp = lds + RL_P + ib * (16 * 144) + b144r;
#pragma unroll
                for (int ks = 0; ks < KS; ++ks) {
                    const bf16x8 pb = *(const LAS bf16x8*)(pp + ks * 64);
                    acc = __builtin_amdgcn_mfma_f32_16x16x32_bf16(vf[ks], pb, acc, 0, 0, 0);
                }
                o[ib] = acc;
                asm volatile("" ::: "memory");
            }
        }
        __builtin_amdgcn_sched_barrier(0);
        {   const ldsp kd = lds + okd + btr;
#pragma unroll
            for (int db = 0; db < 8; ++db) {
                f32x4 acc = S[db] * gL;
#pragma unroll
                for (int ks = 0; ks < KS; ++ks) { const ldsp p = kd + db * 32 + ks * (32 * 272);
                    acc = __builtin_amdgcn_mfma_f32_16x16x32_bf16(cat4(tr_read(p), tr_read(p + 4 * 272)), vf[ks], acc, 0, 0, 0); }
                S[db] = acc;
                if (db & 1) asm volatile("" ::: "memory");
            } }
        __builtin_amdgcn_sched_barrier(0);
        if (FULL) {
#pragma unroll
            for (int ib = 0; ib < NB; ++ib) {
                float s1 = (o[ib][0] + o[ib][1]) + (o[ib][2] + o[ib][3]);
                float s2 = (o[ib][0] * o[ib][0] + o[ib][1] * o[ib][1]) + (o[ib][2] * o[ib][2] + o[ib][3] * o[ib][3]);
                s1 += __shfl_xor(s1, 16); s1 += __shfl_xor(s1, 32); s2 += __shfl_xor(s2, 16); s2 += __shfl_xor(s2, 32);
                if (fq == 0) { f32x2s w; w.x = s1; w.y = s2; *(LAS f32x2s*)(lds + RL_ST + ib * 1024 + wave * 8 + bst) = w; }
            }
            LDS_WAIT(); __syncthreads();
            const int e0 = wave * 16 + fq * 4;
            const f32x4 gnv = *(const f32x4*)(R.gn + h * HD + e0);
#pragma unroll
            for (int ib = 0; ib < NB; ++ib) {
                float s1 = 0.f, s2 = 0.f;
#pragma unroll
                for (int w8 = 0; w8 < 8; ++w8) { const f32x2s w = *(const LAS f32x2s*)(lds + RL_ST + ib * 1024 + w8 * 8 + bst); s1 += w.x; s2 += w.y; }
                const float mu = s1 * (1.0f / HD); float var = s2 * (1.0f / HD) - mu * mu; var = var < 0.f ? 0.f : var;
                const float rstd = __builtin_amdgcn_rsqf(var + EPS);
                const size_t row = (size_t)(row0 + ch * L + ib * 16 + fr);
                const u32x2 gw = gpre[ib];
                const float y0 = silu_f(bf_lo(gw.x)) * ((o[ib][0] - mu) * rstd * gnv.x), y1 = silu_f(bf_hi(gw.x)) * ((o[ib][1] - mu) * rstd * gnv.y);
                const float y2 = silu_f(bf_lo(gw.y)) * ((o[ib][2] - mu) * rstd * gnv.z), y3 = silu_f(bf_hi(gw.y)) * ((o[ib][3] - mu) * rstd * gnv.w);
                u32x2 w; w.x = cvtpk(y0, y1); w.y = cvtpk(y2, y3);
                *(GAS u32x2*)(R.MIX + row * D + h * HD + e0) = w;
                asm volatile("" ::: "memory");
            }
        }
    }
#undef RET_GLOAD
}

__device__ __forceinline__ float lg2_of_head(int h) { return h == 0 ? -0.04580368961312479f : h == 1 ? -0.02272007650008353f : h == 2 ? -0.011315313227834146f : -0.005646563141142063f; }

__device__ __forceinline__ void ret_phase_a(const Frame& F, const RetArgs& R) {
    for (int v = F.vcu; v < 256; v += F.G) {
        const int bh = v >> 3, s = v & 7, b = bh >> 2, h = bh & 3; const float lg2 = lg2_of_head(h);
        for (int half = 0; half < 2; ++half) {
            const int sc = half ? 15 - s : s; if (sc == 15) continue;
            f32x4 S[8];
#pragma unroll
            for (int db = 0; db < 8; ++db) S[db] = (f32x4){0.f, 0.f, 0.f, 0.f};
            ret_item<64, false>(F, R, b * SEQ + sc * 512, h, 8, S, lg2);
            float* T = R.T + (size_t)(bh * 16 + sc) * 16384;
#pragma unroll
            for (int db = 0; db < 8; ++db) *(GAS f32x4*)(T + ((F.wave * 8 + db) * 64 + F.lane) * 4) = S[db];
        }
    }
}
#define LAUNDER_FRFQ() int ln_ = F.lane; asm volatile("" : "+v"(ln_)); const int fr = ln_ & 15, fq = ln_ >> 4
__device__ __forceinline__ void ret_phase_c(const Frame& F, const RetArgs& R) {
    for (int v = F.vcu; v < 256; v += F.G) {
        const int bh = v >> 3, s = v & 7, b = bh >> 2, h = bh & 3; const float lg2 = lg2_of_head(h); const float g512 = fexp2(lg2 * 512.f);
        for (int half = 0; half < 2; ++half) {
            const int sc = half ? 15 - s : s;
            f32x4 S[8];
#pragma unroll
            for (int db = 0; db < 8; ++db) S[db] = (f32x4){0.f, 0.f, 0.f, 0.f};
            {   const float* Tl = R.T + (size_t)(bh * 16) * 16384 + (size_t)(F.wave * 8 * 64 + F.lane) * 4;
                int p = 0;
                for (; p + 4 <= sc; p += 4) {
                    f32x4 t0[8], t1[8], t2[8], t3[8];
#pragma unroll
                    for (int db = 0; db < 8; ++db) { t0[db] = *(const GAS f32x4*)(Tl + (size_t)p * 16384 + db * 256); t1[db] = *(const GAS f32x4*)(Tl + (size_t)(p + 1) * 16384 + db * 256);
                        t2[db] = *(const GAS f32x4*)(Tl + (size_t)(p + 2) * 16384 + db * 256); t3[db] = *(const GAS f32x4*)(Tl + (size_t)(p + 3) * 16384 + db * 256); }
#pragma unroll
                    for (int db = 0; db < 8; ++db) S[db] = (((S[db] * g512 + t0[db]) * g512 + t1[db]) * g512 + t2[db]) * g512 + t3[db];
                }
                for (; p < sc; ++p) {
#pragma unroll
                    for (int db = 0; db < 8; ++db) S[db] = S[db] * g512 + *(const GAS f32x4*)(Tl + (size_t)p * 16384 + db * 256); }
            }
            ret_item<64, true>(F, R, b * SEQ + sc * 512, h, 8, S, lg2);
            if (sc == 15) { LAUNDER_FRFQ(); float* So = R.SoutP + (size_t)bh * 16384;
#pragma unroll
                for (int db = 0; db < 8; ++db)
#pragma unroll
                    for (int t = 0; t < 4; ++t) So[(db * 16 + fq * 4 + t) * HD + F.wave * 16 + fr] = S[db][t]; }
        }
        if (v < 32) {
            const float* Si = R.Sin + (size_t)v * 16384; f32x4 S[8];
            { LAUNDER_FRFQ();
#pragma unroll
            for (int db = 0; db < 8; ++db)
#pragma unroll
                for (int t = 0; t < 4; ++t) S[db][t] = Si[(db * 16 + fq * 4 + t) * HD + F.wave * 16 + fr]; }
            ret_item<32, true>(F, R, MP + (v >> 2) * DSEQ, v & 3, 1, S, lg2_of_head(v & 3));
            LAUNDER_FRFQ(); float* So = R.SoutS + (size_t)v * 16384;
#pragma unroll
            for (int db = 0; db < 8; ++db)
#pragma unroll
                for (int t = 0; t < 4; ++t) So[(db * 16 + fq * 4 + t) * HD + F.wave * 16 + fr] = S[db][t];
        }
    }
}
__device__ __forceinline__ void conv_prompt(const Frame& F, const bf16* U, const bf16* BG, const float* cw, const float* cb, bf16* MIX, int worker, int nworkers) {
    for (int it = worker * 512 + F.tid; it < (MP / 8) * 64; it += nworkers * 512) {
        const int c8 = (it & 63) * 8, row0 = (it >> 6) * 8; const bool first = (row0 & (SEQ - 1)) == 0;
        v4u uw[10], bw[8];
        const GAS v4u* up = (const GAS v4u*)(U + (size_t)row0 * 512 + c8); const GAS v4u* bp = (const GAS v4u*)(BG + (size_t)row0 * 512 + c8);
        uw[0] = first ? (v4u){0u, 0u, 0u, 0u} : up[-128]; uw[1] = first ? (v4u){0u, 0u, 0u, 0u} : up[-64];
#pragma unroll
        for (int r = 0; r < 8; ++r) { uw[2 + r] = up[64 * r]; bw[r] = bp[64 * r]; }
        const f32x4 w0a = *(const f32x4*)(cw + c8), w0b = *(const f32x4*)(cw + c8 + 4), w1a = *(const f32x4*)(cw + CONVD + c8), w1b = *(const f32x4*)(cw + CONVD + c8 + 4);
        const f32x4 w2a = *(const f32x4*)(cw + 2 * CONVD + c8), w2b = *(const f32x4*)(cw + 2 * CONVD + c8 + 4), cba = *(const f32x4*)(cb + c8), cbb = *(const f32x4*)(cb + c8 + 4);
#define CP_LO(v_) ((f32x4){bf_lo((v_).x), bf_hi((v_).x), bf_lo((v_).y), bf_hi((v_).y)})
#define CP_HI(v_) ((f32x4){bf_lo((v_).z), bf_hi((v_).z), bf_lo((v_).w), bf_hi((v_).w)})
#pragma unroll
        for (int r = 0; r < 8; ++r) {
            const f32x4 ya = CP_LO(bw[r]) * (cba + w0a * CP_LO(uw[r]) + w1a * CP_LO(uw[r + 1]) + w2a * CP_LO(uw[r + 2]));
            const f32x4 yb = CP_HI(bw[r]) * (cbb + w0b * CP_HI(uw[r]) + w1b * CP_HI(uw[r + 1]) + w2b * CP_HI(uw[r + 2]));
            v4u w; w.x = cvtpk(ya.x, ya.y); w.y = cvtpk(ya.z, ya.w); w.z = cvtpk(yb.x, yb.y); w.w = cvtpk(yb.z, yb.w);
            *(GAS v4u*)(MIX + (size_t)(row0 + r) * D + 512 + c8) = w;
        }
#undef CP_LO
#undef CP_HI
    }
}
__device__ __forceinline__ void conv_phase(const Frame& F, const bf16* U, const bf16* BG, const float* cw, const float* cb, const float* hist, bf16* MIX, int idx0, int idx1, int worker, int nworkers) {
    for (int idx = idx0 + worker * 512 + F.tid; idx < idx1; idx += nworkers * 512) {
        const int row = idx >> 6, c8 = (idx & 63) * 8;
        int pos, bs = 0; if (row < MP) pos = row & (SEQ - 1); else { pos = (row - MP) & 31; bs = (row - MP) >> 5; }
        const bool smp = row >= MP;
        float u0[8], u1[8], u2[8], bg[8];
        { const v4u w = *(const GAS v4u*)(U + (size_t)row * 512 + c8); u0[0] = bf_lo(w.x); u0[1] = bf_hi(w.x); u0[2] = bf_lo(w.y); u0[3] = bf_hi(w.y); u0[4] = bf_lo(w.z); u0[5] = bf_hi(w.z); u0[6] = bf_lo(w.w); u0[7] = bf_hi(w.w); }
        { const v4u w = *(const GAS v4u*)(BG + (size_t)row * 512 + c8); bg[0] = bf_lo(w.x); bg[1] = bf_hi(w.x); bg[2] = bf_lo(w.y); bg[3] = bf_hi(w.y); bg[4] = bf_lo(w.z); bg[5] = bf_hi(w.z); bg[6] = bf_lo(w.w); bg[7] = bf_hi(w.w); }
        if (pos >= 1) { const v4u w = *(const GAS v4u*)(U + (size_t)(row - 1) * 512 + c8); u1[0] = bf_lo(w.x); u1[1] = bf_hi(w.x); u1[2] = bf_lo(w.y); u1[3] = bf_hi(w.y); u1[4] = bf_lo(w.z); u1[5] = bf_hi(w.z); u1[6] = bf_lo(w.w); u1[7] = bf_hi(w.w); }
        else {
#pragma unroll
            for (int q = 0; q < 8; ++q) u1[q] = smp ? hist[((size_t)bs * 2 + 1) * CONVD + c8 + q] : 0.f; }
        if (pos >= 2) { const v4u w = *(const GAS v4u*)(U + (size_t)(row - 2) * 512 + c8); u2[0] = bf_lo(w.x); u2[1] = bf_hi(w.x); u2[2] = bf_lo(w.y); u2[3] = bf_hi(w.y); u2[4] = bf_lo(w.z); u2[5] = bf_hi(w.z); u2[6] = bf_lo(w.w); u2[7] = bf_hi(w.w); }
        else {
#pragma unroll
            for (int q = 0; q < 8; ++q) u2[q] = smp ? hist[((size_t)bs * 2 + pos) * CONVD + c8 + q] : 0.f; }
        float y[8];
#pragma unroll
        for (int q = 0; q < 8; ++q) { const int c = c8 + q; y[q] = bg[q] * (cb[c] + cw[c] * u2[q] + cw[CONVD + c] * u1[q] + cw[2 * CONVD + c] * u0[q]); }
        v4u w; w.x = cvtpk(y[0], y[1]); w.y = cvtpk(y[2], y[3]); w.z = cvtpk(y[4], y[5]); w.w = cvtpk(y[6], y[7]);
        *(GAS v4u*)(MIX + (size_t)row * D + 512 + c8) = w;
    }
}

constexpr int NPHASE = 25;
#define MK_RETARGS() RetArgs R{Qb, Kb, Vb, Gb, MIXb, (float*)(ws + WS_T), a.in[13] + l * RET, a.in[4] + (size_t)l * 8 * NHEAD * HD * HD, a.out + OFF_SRP + (size_t)l * 8 * NHEAD * HD * HD, a.out + OFF_SRS + (size_t)l * 8 * NHEAD * HD * HD}
#ifndef PG8_SP2
#define PG8_SP2 true
#endif
#ifndef PG8_ALIGN
#define PG8_ALIGN true
#endif

__global__ void __launch_bounds__(NWAVES * 64, 2) fwd_kernel(Args a) {
    extern __shared__ __attribute__((aligned(16))) unsigned char lds_raw[];
    Frame F;
    F.lds = (ldsp)lds_raw; F.tid = threadIdx.x; F.lane = F.tid & 63; F.wave = __builtin_amdgcn_readfirstlane(F.tid >> 6);
    F.G = gridDim.x; { const int bx = blockIdx.x; F.vcu = (F.G % 8 == 0) ? (bx % 8) * (F.G / 8) + bx / 8 : bx; }
    volatile LAS unsigned* MISC = (volatile LAS unsigned*)(F.lds + MISC_OFF);
    for (int u = F.tid; u < (LDS_BYTES - LDSCTL_OFF) / 4; u += NWAVES * 64) ((LAS unsigned*)(F.lds + LDSCTL_OFF))[u] = 0u;
    __syncthreads();
    const bool multi = (a.ph_hi - a.ph_lo) > 1;
    XcdBarrier bar; bar.bar = (unsigned*)(a.ws + WS_CTL) + CW_BAR; bar.x = 0; bar.st = nullptr;
    if (multi) bar = xcd_barrier_post((unsigned*)(a.ws + WS_CTL) + CW_BAR, MISC + 8);

    unsigned char* ws = a.ws;
    bf16* X = (bf16*)(ws + WS_XB);
    bf16* H = (bf16*)(ws + WS_H);
    bf16* ACT = (bf16*)(ws + WS_BIG);
    bf16* Qb = (bf16*)(ws + WS_BIG); bf16* Kb = (bf16*)(ws + WS_BIG + SZ_M512); bf16* Vb = (bf16*)(ws + WS_BIG + 2 * SZ_M512);
    bf16* Gb = (bf16*)(ws + WS_BIG + 3 * SZ_M512); bf16* BGb = (bf16*)(ws + WS_BIG + 4 * SZ_M512); bf16* Ub = (bf16*)(ws + WS_BIG + 5 * SZ_M512);
    const float* rcos = (const float*)(ws + WS_ROPE); const float* rsin = rcos + 8192 * 64;

    const Frame F0 = F;
    for (int ph = a.ph_lo; ph < a.ph_hi; ++ph) {
        if (ph == 2 || ph == 5 || ph == 16) continue;
        { int t_ = F0.tid; asm volatile("" : "+v"(t_)); F.tid = t_; F.lane = t_ & 63; F.wave = __builtin_amdgcn_readfirstlane(t_ >> 6); }
        if (ph == 0) { p0_prologue(F, a); }
        else if (ph == NPHASE - 1) {
            final_norm_phase(F, X, a.out, a.in[20]);
            const float* modp = (const float*)(ws + WS_MOD) + (size_t)(DEPTH - 1) * 16 * MODW;
            CombArgs C{(const float*)(ws + WS_PART), 11, X + (size_t)MP * D, X + (size_t)MP * D, modp + (size_t)8 * D, 0.5f, nullptr, nullptr, nullptr, nullptr};
            const int gw = F.vcu * NWAVES + F.wave, NGW = F.G * NWAVES;
            for (int lr = gw; lr < MS; lr += NGW) { f32x4 xw[4]; float rstd; sample_combine_row(F, C, lr, xw, rstd);
#pragma unroll
                for (int j = 0; j < 4; ++j) { const int c = 4 * F.lane + 256 * j; *(f32x4*)(a.out + (size_t)(MP + lr) * D + c) = (xw[j] * rstd) * *(const f32x4*)(a.in[20] + c); } }
        }
        else if (ph == 1) { prepass_phase(F, a); }
        else {
            const int l = (ph - 2) / 11, kk = (ph - 2) % 11;
            const int k = (kk == 0 || kk == 3 || kk == 8) ? -1 : (kk < 3 ? kk - 1 : kk < 8 ? kk - 2 : kk - 3);
            const float* mod = (const float*)(ws + WS_MOD); const float* modl = mod + (size_t)l * 16 * MODW;
            const unsigned char* wl = ws + WS_W + (size_t)l * W_LAYER;
            const float* SS = (const float*)(ws + WS_SS); float* RS = (float*)(ws + WS_RS); const float* biasl = (const float*)(ws + WS_BIAS) + (size_t)l * BIAS_LAYER;
            bf16* MIXb = (bf16*)(ws + WS_MIX);
            if (k < 0) {
                if (kk == 0 && l == 0) rs_phase(F, SS, RS, MT);
                else {
                    const int lp = (kk == 0) ? l - 1 : l;
                    const float* modp = mod + (size_t)lp * 16 * MODW;
                    const float* gnx = (kk == 3) ? a.in[11] + l * D : (kk == 8) ? a.in[17] + l * D : a.in[8] + l * D;
                    CombArgs C{(const float*)(ws + WS_PART), (kk == 8) ? 4 : 11, X + (size_t)MP * D, X + (size_t)MP * D,
                               modp + (size_t)(kk == 3 ? 2 : kk == 8 ? 5 : 8) * D, (kk == 8) ? 1.0f : 0.5f, H + (size_t)MP * D, gnx, mod + (size_t)l * 16 * MODW + (size_t)(kk == 3 ? 4 : kk == 8 ? 7 : 1) * D, RS + MP};
                    sample_combine(F, C);
                    rs_phase(F, SS, RS, MP);
                }
            }
            else if (k == 0 || k == 6) {
                pg8::Gemm g{H, (const bf16*)(wl + (k == 0 ? W_1I : W_2I)), MT, NFI, D}; ResOrder S; S.init(D, NFI, 1, F.G, (int)blockIdx.x);
                EpiFFN E{F.lds, NFI, ACT, RS, biasl + (k == 0 ? 0 : (size_t)16 * (NFI + NIN))};
                pg8::gemm_phase<EpiFFN, ResOrder, PG8_ALIGN, PG8_SP2>(F.lds, g, S, E);
            } else if (k == 1 || k == 5 || k == 7) {
                pg8::Gemm g{k == 5 ? MIXb : ACT, (const bf16*)(wl + (k == 1 ? W_1O : k == 5 ? W_OUT : W_2O)), MT, D, k == 5 ? D : DFF};
                ResOrder S; S.init(k == 5 ? D : DFF, D, (k == 5 ? D : DFF) / 256, F.G, (int)blockIdx.x);
                const int ln = (k == 7 && l + 1 < DEPTH) ? l + 1 : l;
                const float* gnext = (k == 1) ? a.in[11] + l * D : (k == 5) ? a.in[17] + l * D : (l + 1 < DEPTH ? a.in[8] + ln * D : a.in[20]);
                const float* scn = mod + (size_t)ln * 16 * MODW + (size_t)(k == 1 ? 4 : k == 5 ? 7 : 1) * D;
                EpiRes E{X, X, uni_ptr(modl + (k == 1 ? 2 : k == 5 ? 5 : 8) * D), __builtin_amdgcn_readfirstlane(k == 5 ? 0 : 1), H, uni_ptr(gnext), uni_ptr(scn), (float*)(ws + WS_SS), (float*)(ws + WS_PART)};
                pg8::gemm_phase<EpiRes, ResOrder, PG8_ALIGN, PG8_SP2>(F.lds, g, S, E);
            } else if (k == 2 || k == 3) {
                constexpr int NSU = NIN / 256; const int nsu = (F.G > 2 * NSU) ? NSU : 0;
                pg8::Gemm g{H, (const bf16*)(wl + W_IN), MT, NIN, D}; ResOrder S; S.init(D, NIN, 1, F.G, (int)blockIdx.x);
                if (k == 2) { if (nsu) S.nsl = 0;
                    CombArgs C{(const float*)(ws + WS_PART), 11, X + (size_t)MP * D, X + (size_t)MP * D, modl + (size_t)2 * D, 0.5f, H + (size_t)MP * D, a.in[11] + l * D, modl + (size_t)4 * D, RS + MP};
                    sample_combine(F, C);
                } else { S.nr = 0; S.cs = F.vcu; if (!nsu) S.nsl = 0; }
                EpiMix E{F.lds, NIN, Qb, rcos, rsin, a.out + OFF_SCP + (size_t)l * 8 * 2 * CONVD, a.out + OFF_SCS + (size_t)l * 8 * 2 * CONVD, RS, biasl + (size_t)16 * NFI, SS};
                pg8::gemm_phase<EpiMix, ResOrder, PG8_ALIGN, PG8_SP2>(F.lds, g, S, E);
                if (k == 3) {
                    __syncthreads();
                    { MK_RETARGS(); ret_phase_a(F, R); }
                    if (F.vcu >= nsu) conv_prompt(F, Ub, BGb, a.in[14] + (size_t)l * 3 * CONVD, a.in[15] + (size_t)l * CONVD, MIXb, F.vcu - nsu, F.G - nsu);
                }
            } else {
                conv_phase(F, Ub, BGb, a.in[14] + (size_t)l * 3 * CONVD, a.in[15] + (size_t)l * CONVD, a.in[5] + (size_t)l * 8 * 2 * CONVD, MIXb, MP * 64, MT * 64, F.vcu, F.G);
                { MK_RETARGS(); ret_phase_c(F, R); }
            }
        }
        if (ph + 1 < a.ph_hi) {
            if (a.ph_hi > NPHASE) { __threadfence(); cg::this_grid().sync(); }
            else xcd_barrier(bar);
        }
    }
}

#ifndef MK_SINGLE
#define MK_SINGLE 0
#endif
extern "C" void kernel_launch(void* const* d_in, const int* in_sizes, int n_in, void* d_out, int out_size, void* d_ws, size_t ws_size, hipStream_t stream) {
    static int grid = 0;
    if (grid == 0) {
        if (n_in != 21 || ws_size < WS_END) { fprintf(stderr, "kernel_launch: unexpected problem (n_in %d, ws %zu)\n", n_in, ws_size); grid = -1; return; }
        int dev = 0, cus = 0, per_cu = 0;
        if (hipGetDevice(&dev) != hipSuccess || hipDeviceGetAttribute(&cus, hipDeviceAttributeMultiprocessorCount, dev) != hipSuccess) { grid = -1; return; }
        if (hipFuncSetAttribute((const void*)fwd_kernel, hipFuncAttributeMaxDynamicSharedMemorySize, LDS_BYTES) != hipSuccess) { fprintf(stderr, "kernel_launch: hipFuncSetAttribute failed\n"); grid = -1; return; }
        if (hipOccupancyMaxActiveBlocksPerMultiprocessor(&per_cu, (const void*)fwd_kernel, NWAVES * 64, LDS_BYTES) != hipSuccess || per_cu < 1) { fprintf(stderr, "kernel_launch: occupancy query says %d\n", per_cu); per_cu = 1; }
        (void)hipGetLastError();
        grid = cus * per_cu;
    }
    if (grid < 0) return;
    (void)hipMemsetAsync((char*)d_ws + WS_CTL, 0, CTL_ZERO_BYTES, stream);
    Args a{};
    for (int i = 0; i < 21; ++i) a.in[i] = (const float*)d_in[i];
    a.out = (float*)d_out; a.ws = (unsigned char*)d_ws;
#if MK_SINGLE
    a.ph_lo = 0; a.ph_hi = NPHASE;
    void* args[] = {&a};
    hipError_t e = hipLaunchCooperativeKernel((const void*)fwd_kernel, dim3(grid), dim3(NWAVES * 64), args, LDS_BYTES, stream);
    if (e != hipSuccess) fprintf(stderr, "cooperative launch failed: %s (grid %d)\n", hipGetErrorString(e), grid);
#else
    for (int ph = 0; ph < NPHASE; ++ph) {
        a.ph_lo = ph; a.ph_hi = ph + 1;
        hipLaunchKernelGGL(fwd_kernel, dim3(grid), dim3(NWAVES * 64), LDS_BYTES, stream, a);
    }
#endif
}
```

```cpp
#include <hip/hip_runtime.h>
#include <hip/hip_cooperative_groups.h>
#include <cstdio>
#include <cstdint>
namespace cg = cooperative_groups;
#define MK_SINGLE 1
namespace pg8 {
#define PG8_LAS __attribute__((address_space(3)))
typedef unsigned short bf16_t;
typedef short bf16x8 __attribute__((ext_vector_type(8)));
typedef float f32x4 __attribute__((ext_vector_type(4)));
typedef unsigned u32x4 __attribute__((ext_vector_type(4)));
constexpr int BM = 256, BK = 64, HALF = 128, HTB = HALF * BK * 2  , STAGE_BYTES = 8 * HTB, NXCD = 8, WGM = 4;

__host__ __device__ __forceinline__ int lds_byte(int r, int c) { const int st = (r >> 4) * 2 + (c >> 5), rr = r & 15, cc = c & 31, ob = rr * 64 + cc * 2; return st * 1024 + (ob ^ (((ob >> 9) & 1) << 5)); }
__host__ __device__ __forceinline__ void stage_rc(int b, int& R, int& C) { const int st = b / 1024, sb = b % 1024, swz = sb ^ (((sb >> 9) & 1) << 5); R = (st >> 1) * 16 + swz / 64; C = (st & 1) * 32 + (swz % 64) / 2; }
__host__ __device__ __forceinline__ int perm32(int rho) { const int n = rho >> 4, i = rho & 15; return 8 * (i >> 2) + 4 * n + (i & 3); }

struct Unit { int pm, pn, kt0, nkt, tab; };
struct Gemm { const bf16_t* A; const bf16_t* Bt; int M, N, K; };

struct StaticOrder {
    int nM, nN, nwg, G, c, ntf;
    __host__ __device__ void init(int M, int N, int G_, int c_) { nM = M / BM; nN = N / BM; nwg = nM * nN; G = G_; c = c_; }
    __host__ __device__ bool next(int i, Unit& u) const {
        const long L = (long)i * G + c; if (L >= nwg) return false;
        int wgid = (int)L; { const int q = nwg / NXCD, r = nwg % NXCD, xcd = wgid % NXCD, off = wgid / NXCD; wgid = (xcd < r ? xcd * (q + 1) : r * (q + 1) + (xcd - r) * q) + off; }
        const int nig = WGM * nN, gid = wgid / nig, fm = gid * WGM, gsz = (nM - fm) < WGM ? (nM - fm) : WGM;
        u.pm = fm + ((wgid % nig) % gsz); u.pn = (wgid % nig) / gsz; u.kt0 = 0; u.nkt = ntf; return true;
    }
    __device__ __forceinline__ void a_ready(const Unit&) const {}
    __device__ __forceinline__ void done(const Unit&) const {}
};
__device__ __forceinline__ unsigned cvt_pk_bf16(float lo, float hi) { unsigned r; asm volatile("v_cvt_pk_bf16_f32 %0, %1, %2" : "=v"(r) : "v"(lo), "v"(hi)); return r; }
template <class Epi, class Sched, bool ALIGN_EPI = false, bool SP2 = false>
__device__ __forceinline__ void gemm_phase(PG8_LAS unsigned char* lds, const Gemm g, const Sched& S, const Epi& E) {
    int tid_l = threadIdx.x; asm volatile("" : "+v"(tid_l));
    const int tid = tid_l, wid = __builtin_amdgcn_readfirstlane(tid >> 6), lane = tid & 63, wr = wid >> 2, wc = wid & 3, fr = lane & 15, fq = lane >> 4;
    const int K = g.K; int nt;
    unsigned voffA[2], voffB[2];
#pragma unroll
    for (int i = 0; i < 2; ++i) { int R, C; stage_rc(tid * 16 + i * 8192, R, C); const int Rb = Epi::PERM ? ((R & ~31) + perm32(R & 31)) : R;
        voffA[i] = (unsigned)(R * K + C) * 2u; voffB[i] = (unsigned)(Rb * K + C) * 2u; }
    const size_t kstep = (size_t)(BK * 2);
    const size_t hstep = (size_t)HALF * K * 2;
    const size_t tstep = 2 * hstep;
    const unsigned ldsw = (unsigned)wid * 1024u;
    const int aoff = lds_byte(wr * 64 + fr, fq * 8), boff = lds_byte(wc * 32 + fr, fq * 8);
#define PG8_SA(b, h) (((b) * 2 + (h)) * HTB)
#define PG8_SB(b, h) ((4 + (b) * 2 + (h)) * HTB)
#define PG8_STAGE(bufoff, gbase, voff) do { _Pragma("unroll") for (int _i = 0; _i < 2; ++_i) \
        __builtin_amdgcn_global_load_lds((const unsigned*)((const char*)(gbase) + (voff)[_i]), (PG8_LAS unsigned*)(lds + (bufoff) + ldsw + _i * 8192), 16, 0, 0); } while (0)
#define PG8_LDA(dst, b, h) do { _Pragma("unroll") for (int m = 0; m < 4; ++m) _Pragma("unroll") for (int k = 0; k < 2; ++k) dst[m][k] = *(const PG8_LAS bf16x8*)(lds + PG8_SA(b, h) + aoff + m * 2048 + k * 1024); } while (0)
#define PG8_LDB(dst, b, h) do { _Pragma("unroll") for (int n = 0; n < 2; ++n) _Pragma("unroll") for (int k = 0; k < 2; ++k) dst[n][k] = *(const PG8_LAS bf16x8*)(lds + PG8_SB(b, h) + boff + n * 2048 + k * 1024); } while (0)
#define PG8_MMA(ai, bj, At, Bt) do { __builtin_amdgcn_s_setprio(1); _Pragma("unroll") for (int m = 0; m < 4; ++m) _Pragma("unroll") for (int n = 0; n < 2; ++n) _Pragma("unroll") for (int k = 0; k < 2; ++k) \
        acc[ai][bj][m][n] = __builtin_amdgcn_mfma_f32_16x16x32_bf16(Bt[n][k], At[m][k], acc[ai][bj][m][n], 0, 0, 0); __builtin_amdgcn_s_setprio(0); } while (0)
#define PG8_WAIT_V(n) asm volatile("s_waitcnt vmcnt(" #n ")" ::: "memory")
#define PG8_WAIT_L(n) asm volatile("s_waitcnt lgkmcnt(" #n ")" ::: "memory")
#define PG8_BAR __builtin_amdgcn_s_barrier()
#define PG8_SCHED __builtin_amdgcn_sched_barrier(0)
    Unit cur, nxt; int ui = 0;
    if (!S.next(0, cur)) return;
    nt = cur.nkt; cur.tab = 0; nxt.tab = 0;
    if constexpr (Epi::HAS_TAB) { cur.tab = E.tab_off(0); const float pv0 = E.pre_load(cur, wid, lane); E.pre_store(pv0, cur, wid, lane); }
    f32x4 acc[2][2][4][2];
#pragma unroll
    for (int a = 0; a < 2; ++a)
#pragma unroll
        for (int b = 0; b < 2; ++b)
#pragma unroll
            for (int m = 0; m < 4; ++m)
#pragma unroll
                for (int n = 0; n < 2; ++n) acc[a][b][m][n] = (f32x4){0.f, 0.f, 0.f, 0.f};
    bf16x8 At[4][2], B0[2][2], B1[2][2];
    const char* cA = (const char*)g.A + (size_t)cur.pm * tstep + (size_t)cur.kt0 * kstep; const char* cB = (const char*)g.Bt + (size_t)cur.pn * tstep + (size_t)cur.kt0 * kstep;
    S.a_ready(cur);
    if constexpr (SP2) {
        PG8_STAGE(PG8_SB(0, 0), cB, voffB); PG8_STAGE(PG8_SB(0, 1), cB + hstep, voffB); PG8_STAGE(PG8_SA(0, 0), cA, voffA); PG8_STAGE(PG8_SA(0, 1), cA + hstep, voffA);
        if (wr == 1) PG8_BAR;
        PG8_WAIT_V(2); PG8_BAR;
        PG8_STAGE(PG8_SB(1, 0), cB + kstep, voffB); PG8_STAGE(PG8_SA(1, 0), cA + kstep, voffA); PG8_STAGE(PG8_SB(1, 1), cB + hstep + kstep, voffB);
        PG8_WAIT_V(6); PG8_BAR;
    } else {
        PG8_STAGE(PG8_SB(0, 0), cB, voffB); PG8_STAGE(PG8_SA(0, 0), cA, voffA); PG8_STAGE(PG8_SB(0, 1), cB + hstep, voffB); PG8_STAGE(PG8_SA(0, 1), cA + hstep, voffA);
        if (wr == 1) PG8_BAR;
        PG8_WAIT_V(4); PG8_BAR;
        PG8_STAGE(PG8_SB(1, 0), cB + kstep, voffB); PG8_STAGE(PG8_SA(1, 0), cA + kstep, voffA); PG8_STAGE(PG8_SB(1, 1), cB + hstep + kstep, voffB);
        PG8_WAIT_V(6); PG8_BAR;
    }
    for (;;) {
        const bool has_next = S.next(ui + 1, nxt);
        if constexpr (Epi::HAS_TAB) nxt.tab = E.tab_off((ui + 1) & 1);
        const char* nA = has_next ? (const char*)g.A + (size_t)nxt.pm * tstep + (size_t)nxt.kt0 * kstep : cA; const char* nB = has_next ? (const char*)g.Bt + (size_t)nxt.pn * tstep + (size_t)nxt.kt0 * kstep : cB;
        for (int t = 0; t < nt; t += 2) {
            const bool last = (t == nt - 2);
            const char* a1 = cA + (size_t)(t + 1) * kstep;
            const char* a2 = last ? nA : cA + (size_t)(t + 2) * kstep; const char* b2 = last ? nB : cB + (size_t)(t + 2) * kstep;
            const char* a3 = a2 + kstep; const char* b3 = b2 + kstep;
            if (last && has_next) S.a_ready(nxt);
            if constexpr (SP2) {
            PG8_LDB(B0, 0, 0); PG8_LDB(B1, 0, 1); PG8_SCHED; PG8_LDA(At, 0, 0); PG8_STAGE(PG8_SA(1, 1), a1 + hstep, voffA);
            PG8_WAIT_V(8); PG8_WAIT_L(0); PG8_BAR; PG8_MMA(0, 0, At, B0); PG8_MMA(0, 1, At, B1); PG8_BAR; PG8_SCHED;
            PG8_LDA(At, 0, 1); PG8_STAGE(PG8_SB(0, 0), b2, voffB); PG8_STAGE(PG8_SB(0, 1), b2 + hstep, voffB); PG8_STAGE(PG8_SA(0, 0), a2, voffA);
            PG8_WAIT_V(8); PG8_WAIT_L(0); PG8_BAR; PG8_MMA(1, 0, At, B0); PG8_MMA(1, 1, At, B1); PG8_BAR; PG8_SCHED;
            PG8_LDB(B0, 1, 0); PG8_LDB(B1, 1, 1); PG8_SCHED; PG8_LDA(At, 1, 0); PG8_STAGE(PG8_SA(0, 1), a2 + hstep, voffA);
            PG8_WAIT_V(8); PG8_WAIT_L(0); PG8_BAR; PG8_MMA(0, 0, At, B0); PG8_MMA(0, 1, At, B1); PG8_BAR; PG8_SCHED;
            PG8_LDA(At, 1, 1); PG8_STAGE(PG8_SB(1, 0), b3, voffB); PG8_STAGE(PG8_SB(1, 1), b3 + hstep, voffB); PG8_STAGE(PG8_SA(1, 0), a3, voffA);
            PG8_WAIT_V(8); PG8_WAIT_L(0); PG8_BAR; PG8_MMA(1, 0, At, B0); PG8_MMA(1, 1, At, B1); PG8_BAR; PG8_SCHED;
            } else {
            PG8_LDB(B0, 0, 0); PG8_SCHED; PG8_LDA(At, 0, 0); PG8_STAGE(PG8_SA(1, 1), a1 + hstep, voffA);
            PG8_WAIT_L(8); PG8_BAR; PG8_WAIT_L(0); PG8_MMA(0, 0, At, B0); PG8_BAR; PG8_SCHED;
            PG8_LDB(B1, 0, 1); PG8_STAGE(PG8_SB(0, 0), b2, voffB);
            PG8_BAR; PG8_WAIT_L(0); PG8_MMA(0, 1, At, B1); PG8_BAR;
            PG8_LDA(At, 0, 1); PG8_STAGE(PG8_SA(0, 0), a2, voffA);
            PG8_BAR; PG8_WAIT_L(0); PG8_MMA(1, 0, At, B0); PG8_BAR; PG8_SCHED;
            PG8_STAGE(PG8_SB(0, 1), b2 + hstep, voffB);
            PG8_WAIT_V(6); PG8_BAR; PG8_MMA(1, 1, At, B1); PG8_BAR;
            PG8_LDB(B0, 1, 0); PG8_SCHED; PG8_LDA(At, 1, 0); PG8_STAGE(PG8_SA(0, 1), a2 + hstep, voffA);
            PG8_WAIT_L(8); PG8_BAR; PG8_WAIT_L(0); PG8_MMA(0, 0, At, B0); PG8_BAR; PG8_SCHED;
            PG8_LDB(B1, 1, 1); PG8_STAGE(PG8_SB(1, 0), b3, voffB);
            PG8_BAR; PG8_WAIT_L(0); PG8_MMA(0, 1, At, B1); PG8_BAR;
            PG8_LDA(At, 1, 1); PG8_STAGE(PG8_SA(1, 0), a3, voffA);
            PG8_BAR; PG8_WAIT_L(0); PG8_MMA(1, 0, At, B0); PG8_BAR; PG8_SCHED;
            PG8_STAGE(PG8_SB(1, 1), b3 + hstep, voffB);
            PG8_WAIT_V(6); PG8_BAR; PG8_MMA(1, 1, At, B1); PG8_BAR;
            }
        }
        if constexpr (ALIGN_EPI) { if (wr == 0) PG8_BAR; }
        if constexpr (!Epi::AFTER_DRAIN) {
            float pv = 0.f; if constexpr (Epi::HAS_TAB) { if (has_next) pv = E.pre_load(nxt, wid, lane); }
            E(acc, cur, wr, wc, fr, fq);
            if constexpr (Epi::HAS_TAB) { if (has_next) E.pre_store(pv, nxt, wid, lane); }
            S.done(cur); }
        if (!has_next) break;
#pragma unroll
        for (int a = 0; a < 2; ++a)
#pragma unroll
            for (int b = 0; b < 2; ++b)
#pragma unroll
                for (int m = 0; m < 4; ++m)
#pragma unroll
                    for (int n = 0; n < 2; ++n) acc[a][b][m][n] = (f32x4){0.f, 0.f, 0.f, 0.f};
        cur = nxt; cA = nA; cB = nB; ++ui; nt = cur.nkt;
        if constexpr (ALIGN_EPI) { if (wr == 1) PG8_BAR; }
    }
    PG8_WAIT_V(0);
    if constexpr (!ALIGN_EPI) { if (wr == 0) PG8_BAR; }
    PG8_BAR;
    if constexpr (Epi::AFTER_DRAIN) { E.fused(acc, cur, wr, wc, fr, fq, lds, wid, lane); S.done(cur); }
#undef PG8_SA
#undef PG8_SB
#undef PG8_STAGE
#undef PG8_LDA
#undef PG8_LDB
#undef PG8_MMA
#undef PG8_WAIT_V
#undef PG8_WAIT_L
#undef PG8_BAR
#undef PG8_SCHED
}
}
#define GAS __attribute__((address_space(1)))
#define LAS __attribute__((address_space(3)))
typedef unsigned short bf16;
typedef unsigned v4u __attribute__((ext_vector_type(4)));
typedef float f32x4 __attribute__((ext_vector_type(4)));
typedef short bf16x8 __attribute__((ext_vector_type(8)));
typedef GAS unsigned gu32;
typedef GAS unsigned long long gu64;
#define RLX_AGENT __ATOMIC_RELAXED, __HIP_MEMORY_SCOPE_AGENT
#define LDS_WAIT() asm volatile("s_waitcnt lgkmcnt(0)" ::: "memory")
#define VM_WAIT() asm volatile("s_waitcnt vmcnt(0)" ::: "memory")
__device__ __forceinline__ unsigned long long rt() { return __builtin_amdgcn_s_memrealtime(); }
__device__ __forceinline__ unsigned f2bf(float f) { unsigned u = __builtin_bit_cast(unsigned, f); return (u + 0x7fffu + ((u >> 16) & 1u)) >> 16; }
__device__ __forceinline__ unsigned pk2(float lo, float hi) { return f2bf(lo) | (f2bf(hi) << 16); }

#define XB_TMO      128
#define XB_XCNT(j)  (256  + 64 * (j))
#define XB_XSUB(j)  (1280 + 64 * (j))
#define XB_XGEN(j)  (2304 + 64 * (j))
#define XB_TOP      3328
#define XB_TOPGEN   3392
#define XCD_BAR_WORDS 3456
#define XB_SPIN_CAP (1u << 18)

__device__ __forceinline__ unsigned xb_ld(unsigned* p)              { return __hip_atomic_load(p, __ATOMIC_RELAXED, __HIP_MEMORY_SCOPE_AGENT); }
__device__ __forceinline__ unsigned xb_add(unsigned* p, unsigned v) { return __hip_atomic_fetch_add(p, v, __ATOMIC_RELAXED, __HIP_MEMORY_SCOPE_AGENT); }
__device__ __forceinline__ unsigned xb_xcc_id() { return (unsigned)__builtin_amdgcn_s_getreg((3 << 11) | 20) & 0xFu; }
#define XB_SPIN(cond, bar) do { unsigned _sp = 0; while (cond) { __builtin_amdgcn_s_sleep(1); \
    if ((++_sp & 255u) == 0u) { if (xb_ld(&(bar)[XB_TMO])) break; if (_sp > XB_SPIN_CAP) { atomicAdd(&(bar)[XB_TMO], 1u); break; } } } } while (0)

struct XcdBarrier {
    unsigned* bar; unsigned x;
    volatile LAS unsigned* st;
};

__device__ __forceinline__ XcdBarrier xcd_barrier_post(unsigned* bar, volatile LAS unsigned* st) {
    XcdBarrier b; b.bar = bar; b.x = xb_xcc_id(); b.st = st;
    if (threadIdx.x == 0) (void)xb_add(&bar[XB_XCNT(b.x)], 1u);
    return b;
}
__device__ __forceinline__ void xcd_barrier_complete(unsigned* bar, unsigned x, unsigned& nloc, unsigned& nx) {
    const unsigned G = gridDim.x * gridDim.y * gridDim.z;
    unsigned sum, cnt, mine, sp = 0u;
    for (;;) {
        sum = 0u; cnt = 0u; mine = 0u;
#pragma unroll
        for (unsigned j = 0; j < 16; ++j) { const unsigned c = xb_ld(&bar[XB_XCNT(j)]); sum += c; cnt += (c > 0u) ? 1u : 0u; mine = (j == x) ? c : mine; }
        if (sum == G) break;
        __builtin_amdgcn_s_sleep(1);
        if ((++sp & 255u) == 0u) { if (xb_ld(&bar[XB_TMO])) break; if (sp > XB_SPIN_CAP) { atomicAdd(&bar[XB_TMO], 1u); break; } }
    }
    nloc = mine > 0u ? mine : 1u; nx = cnt > 0u ? cnt : 1u;
}

__device__ __forceinline__ void xcd_barrier(const XcdBarrier& b) {
    asm volatile("s_waitcnt vmcnt(0)" ::: "memory");
    __syncthreads();
    if (threadIdx.x == 0) {
        unsigned* bar = b.bar;
        __builtin_amdgcn_s_waitcnt(0);
        unsigned nloc = b.st[0], nx = b.st[1];
        if (nloc == 0u) { xcd_barrier_complete(bar, b.x, nloc, nx); b.st[0] = nloc; b.st[1] = nx; }
        const unsigned old = xb_add(&bar[XB_XSUB(b.x)], 1u);
        const unsigned gen = old / nloc;
        if (old + 1u == (gen + 1u) * nloc) {
            __builtin_amdgcn_fence(__ATOMIC_RELEASE, "agent");
            asm volatile("s_waitcnt vmcnt(0)" ::: "memory");
            const unsigned og = xb_add(&bar[XB_TOP], 1u);
            const unsigned tg = og / nx;
            if (og + 1u == (tg + 1u) * nx) xb_add(&bar[XB_TOPGEN], 1u);
            else XB_SPIN(xb_ld(&bar[XB_TOPGEN]) == tg, bar);
            __builtin_amdgcn_fence(__ATOMIC_ACQUIRE, "agent");
            xb_add(&bar[XB_XGEN(b.x)], 1u);
            asm volatile("s_waitcnt vmcnt(0)" ::: "memory");
        } else {
            XB_SPIN(xb_ld(&bar[XB_XGEN(b.x)]) == gen, bar);
            __builtin_amdgcn_fence(__ATOMIC_ACQUIRE, "agent");
            asm volatile("s_waitcnt vmcnt(0)" ::: "memory");
        }
    }
    __syncthreads();
}

constexpr int NWAVES = 8;
constexpr int D = 1024, DFF = 2816, NFI = 2 * DFF, NIN = 3584, NMOD = 9, MODW = NMOD * D;
constexpr int NB_P = 8, SEQ = 8192, NB_S = 8, DSEQ = 32, PAST = 4096, DEPTH = 2;
constexpr int MP = NB_P * SEQ, MS = NB_S * DSEQ, MT = MP + MS;
constexpr int NHEAD = 4, HD = 128, RET = 512, CONVD = 512;
constexpr float EPS = 1e-6f;
constexpr size_t OFF_Y = 0, OFF_SRP = (size_t)MT * D, SZ_SR = (size_t)DEPTH * 8 * NHEAD * HD * HD, OFF_SCP = OFF_SRP + SZ_SR, SZ_SC = (size_t)DEPTH * 8 * 2 * CONVD,
                 OFF_SRS = OFF_SCP + SZ_SC, OFF_SCS = OFF_SRS + SZ_SR;
constexpr size_t MiB = 1u << 20;
constexpr size_t WS_CTL = 0, CTL_ZERO_BYTES = 64 * 1024;
constexpr size_t WS_MOD = 1 * MiB;
constexpr size_t WS_ROPE = 3 * MiB;
constexpr size_t WS_W = 8 * MiB;
constexpr size_t W_1I = 0, W_1O = 11 * MiB, W_IN = 17 * MiB, W_OUT = 24 * MiB, W_2I = 26 * MiB, W_2O = 37 * MiB, W_LAYER = 43 * MiB;
constexpr size_t WS_T = 96 * MiB;
constexpr size_t WS_H = 128 * MiB;
constexpr size_t WS_BIG = 260 * MiB;
constexpr size_t SZ_M512 = (size_t)MT * 512 * 2;
constexpr size_t WS_BIAS = 94 * MiB;
constexpr size_t BIAS_LAYER = (size_t)16 * (2 * NFI + NIN);
constexpr size_t WS_SS = 646 * MiB;
constexpr size_t WS_RS = 651 * MiB;
constexpr size_t WS_MIX = 652 * MiB;
constexpr size_t WS_PART = 784 * MiB;
constexpr size_t WS_XB = 800 * MiB;
constexpr size_t WS_END = WS_XB + (size_t)MT * D * 2;
static_assert(WS_PART + (size_t)11 * MS * D * 4 <= WS_XB, "ws map 3");
static_assert(WS_MIX + (size_t)MT * D * 2 <= WS_PART, "ws map 2");
static_assert(WS_BIG + 6 * SZ_M512 <= WS_SS && WS_SS + (size_t)MT * 64 <= WS_MIX && WS_W + 2 * W_LAYER <= WS_BIAS && WS_BIAS + 2 * BIAS_LAYER * 4 <= WS_T, "ws map");
static_assert((size_t)MT * DFF * 2 <= 6 * SZ_M512, "overlay");
constexpr int CW_BAR = 4096;
constexpr int RING_BYTES = 131072, LDSCTL_OFF = RING_BYTES, MISC_OFF = LDSCTL_OFF + 320, LDS_BYTES = 147456;
constexpr int TAB_OFF = RING_BYTES + 1024, TAB_BYTES = 2048;

typedef unsigned u32x2 __attribute__((ext_vector_type(2)));
typedef short s16x4 __attribute__((ext_vector_type(4)));
typedef float f32x2s __attribute__((ext_vector_type(2)));
typedef LAS unsigned char* ldsp;

struct Frame { ldsp lds; int tid, lane, wave, vcu, G; };

__device__ __forceinline__ float wave_sum(float v) {
#pragma unroll
    for (int o = 1; o < 64; o <<= 1) v += __shfl_xor(v, o);
    return v;
}
__device__ __forceinline__ float fexp2(float x) { return __builtin_amdgcn_exp2f(x); }
__device__ __forceinline__ float silu_f(float x) { return x * __builtin_amdgcn_rcpf(1.0f + fexp2(-1.4426950408889634f * x)); }
__device__ __forceinline__ float bf_lo(unsigned w) { return __builtin_bit_cast(float, w << 16); }
__device__ __forceinline__ float bf_hi(unsigned w) { return __builtin_bit_cast(float, w & 0xffff0000u); }
__device__ __forceinline__ unsigned cvtpk(float lo, float hi) { return pg8::cvt_pk_bf16(lo, hi); }

__device__ __forceinline__ int src_col(int type, int n) {
    if (type == 0) return n;
    const int pn = n >> 8, bj = (n >> 7) & 1, t = n & 127;
    if (type == 1) return bj * DFF + (pn << 7) + t;
    if (pn < 4) { const int base = (pn < 2) ? 0 : 512; return base + (2 * (pn & 1) + (t >> 6)) * 128 + 64 * bj + (t & 63); }
    if (pn < 8) return n;
    if (pn < 12) return 2560 + bj * 512 + ((pn - 8) << 7) + t;
    return 2048 + (n - 3072);
}
__device__ __forceinline__ void p0_transpose_item(const float* W, int K, int N, bf16* WT, int type, LAS float* scr, int item, int lane) {
    const int nblk = N / 32, kb = item / nblk, nb = item % nblk, k0 = 64 * kb, n0 = 32 * nb;
    const int sc = src_col(type, n0 + (lane & 31));
    float tv[32];
#pragma unroll
    for (int i = 0; i < 32; ++i) tv[i] = W[(size_t)(k0 + 2 * i + (lane >> 5)) * N + sc];
#pragma unroll
    for (int i = 0; i < 32; ++i) scr[(2 * i + (lane >> 5)) * 33 + (lane & 31)] = tv[i];
    LDS_WAIT(); asm volatile("" ::: "memory");
    const int c = lane & 7;
#pragma unroll
    for (int j = 0; j < 4; ++j) { const int n = (lane >> 3) + 8 * j; const LAS float* s = scr + (8 * c) * 33 + n;
        v4u o; o.x = pk2(s[0 * 33], s[1 * 33]); o.y = pk2(s[2 * 33], s[3 * 33]); o.z = pk2(s[4 * 33], s[5 * 33]); o.w = pk2(s[6 * 33], s[7 * 33]);
        *(GAS v4u*)(WT + (size_t)(n0 + n) * K + k0 + 8 * c) = o; }
    LDS_WAIT(); asm volatile("" ::: "memory");
}

struct Args { const float* in[21]; float* out; unsigned char* ws; int ph_lo, ph_hi; };
__device__ __forceinline__ void gemv16_item(const Frame& F, LAS float* sc, LAS float* red, const float* wcol, int ldw, const float* addv, float* out, int ldo) {
    float acc[16];
#pragma unroll
    for (int bb = 0; bb < 16; ++bb) acc[bb] = 0.f;
    const int k0 = F.wave * 128;
    for (int kb = 0; kb < 128; kb += 32) {
    float wvv[32];
#pragma unroll
    for (int q = 0; q < 32; ++q) wvv[q] = wcol[(size_t)(k0 + kb + q) * ldw];
#pragma unroll
    for (int q = 0; q < 32; ++q) {
        const int k = kb + q; const float wv = wvv[q];
        const LAS f32x4* s4 = (const LAS f32x4*)(sc + (k0 + k) * 16);
        const f32x4 s0 = s4[0], s1 = s4[1], s2 = s4[2], s3 = s4[3];
        acc[0] += s0.x * wv; acc[1] += s0.y * wv; acc[2] += s0.z * wv; acc[3] += s0.w * wv;
        acc[4] += s1.x * wv; acc[5] += s1.y * wv; acc[6] += s1.z * wv; acc[7] += s1.w * wv;
        acc[8] += s2.x * wv; acc[9] += s2.y * wv; acc[10] += s2.z * wv; acc[11] += s2.w * wv;
        acc[12] += s3.x * wv; acc[13] += s3.y * wv; acc[14] += s3.z * wv; acc[15] += s3.w * wv;
    }
    }
#pragma unroll
    for (int bb = 0; bb < 16; ++bb) red[(F.wave * 16 + bb) * 64 + F.lane] = acc[bb];
    __syncthreads();
    for (int o = F.tid; o < 16 * 64; o += 512) { const int bb = o >> 6, c = o & 63; float s = addv ? addv[c] : 0.f;
#pragma unroll
        for (int w8 = 0; w8 < 8; ++w8) s += red[(w8 * 16 + bb) * 64 + c];
        out[(size_t)bb * ldo + c] = s; }
    __syncthreads();
}

__device__ __forceinline__ void p0_prologue(const Frame& F, const Args& a) {
    {
        LAS float* scr = (LAS float*)(F.lds + F.wave * 16384);
        const int gw = F.vcu * NWAVES + F.wave, NGW = F.G * NWAVES;
        constexpr int I_FI = (D / 64) * (NFI / 32), I_FO = (DFF / 64) * (D / 32), I_IN = (D / 64) * (NIN / 32), I_OUT = (D / 64) * (D / 32);
        constexpr int I_LAYER = 2 * I_FI + 2 * I_FO + I_IN + I_OUT;
        for (int it = gw; it < DEPTH * I_LAYER; it += NGW) {
            const int l = it / I_LAYER; int r = it % I_LAYER;
            bf16* wl = (bf16*)(a.ws + WS_W + (size_t)l * W_LAYER);
            if (r < I_FI) { p0_transpose_item(a.in[9] + (size_t)l * D * NFI, D, NFI, (bf16*)((unsigned char*)wl + W_1I), 1, scr, r, F.lane); continue; } r -= I_FI;
            if (r < I_FO) { p0_transpose_item(a.in[10] + (size_t)l * DFF * D, DFF, D, (bf16*)((unsigned char*)wl + W_1O), 0, scr, r, F.lane); continue; } r -= I_FO;
            if (r < I_IN) { p0_transpose_item(a.in[12] + (size_t)l * D * NIN, D, NIN, (bf16*)((unsigned char*)wl + W_IN), 2, scr, r, F.lane); continue; } r -= I_IN;
            if (r < I_OUT) { p0_transpose_item(a.in[16] + (size_t)l * D * D, D, D, (bf16*)((unsigned char*)wl + W_OUT), 0, scr, r, F.lane); continue; } r -= I_OUT;
            if (r < I_FI) { p0_transpose_item(a.in[18] + (size_t)l * D * NFI, D, NFI, (bf16*)((unsigned char*)wl + W_2I), 1, scr, r, F.lane); continue; } r -= I_FI;
            p0_transpose_item(a.in[19] + (size_t)l * DFF * D, DFF, D, (bf16*)((unsigned char*)wl + W_2O), 0, scr, r, F.lane);
        }
    }
    {
        float* rc = (float*)(a.ws + WS_ROPE); float* rs = rc + 8192 * 64;
        for (int idx = F.vcu * 512 + F.tid; idx < 8192 * 64; idx += F.G * 512) {
            const int pos = idx >> 6, i = idx & 63;
            double inv = 1.0; for (int q = 0; q < i; ++q) inv *= 0.8659643233600653;
            const double ang = (double)pos * inv;
            const double rev = ang * 0.15915494309189535; const double fr = rev - __builtin_rint(rev);
            const float r = (float)(fr * 6.283185307179586);
            rc[idx] = __cosf(r); rs[idx] = __sinf(r);
        }
    }
    __syncthreads();
    {
        LAS float* sc = (LAS float*)F.lds;
        LAS float* red = (LAS float*)(F.lds + 65536);
#pragma unroll 8
        for (int e = F.tid; e < 16 * D; e += 512) { const int bb = e >> 10, k = e & 1023; const float v = (bb < 8) ? a.in[2][bb * D + k] : a.in[3][(bb - 8) * D + k]; sc[k * 16 + bb] = silu_f(v); }
        __syncthreads();
        float* mod = (float*)(a.ws + WS_MOD);
        constexpr int NITEM = DEPTH * (MODW / 64);
        for (int it = F.vcu; it < NITEM; it += F.G) {
            const int l = it / (MODW / 64), n0 = (it % (MODW / 64)) * 64;
            gemv16_item(F, sc, red, a.in[6] + (size_t)l * D * MODW + n0 + F.lane, MODW, a.in[7] + (size_t)l * MODW + n0, mod + (size_t)l * 16 * MODW + n0, MODW);
        }
    }
}

__device__ __forceinline__ void prepass_phase(const Frame& F, const Args& a) {
    LAS float* sc = (LAS float*)F.lds; LAS float* red = (LAS float*)(F.lds + 65536);
    const float* mod = (const float*)(a.ws + WS_MOD); float* bias = (float*)(a.ws + WS_BIAS);
    constexpr int I1 = NFI / 64, I2 = NIN / 64, IL = 2 * I1 + I2;
    for (int it = F.vcu; it < DEPTH * IL; it += F.G) {
        const int l = it / IL; int r = it % IL; int mat = 0; if (r >= I1) { r -= I1; mat = 1; if (r >= I2) { r -= I2; mat = 2; } }
        const int N = (mat == 1) ? NIN : NFI, type = (mat == 1) ? 2 : 1, n0 = r * 64;
        const float* W = (mat == 0) ? a.in[9] + (size_t)l * D * NFI : (mat == 1) ? a.in[12] + (size_t)l * D * NIN : a.in[18] + (size_t)l * D * NFI;
        const float* shv = mod + (size_t)l * 16 * MODW + (size_t)(3 * mat) * D;
#pragma unroll 8
        for (int e = F.tid; e < 16 * D; e += 512) { const int bb = e >> 10, k = e & 1023; sc[k * 16 + bb] = shv[(size_t)bb * MODW + k]; }
        __syncthreads();
        float* out = bias + (size_t)l * BIAS_LAYER + (mat == 0 ? 0 : mat == 1 ? (size_t)16 * NFI : (size_t)16 * (NFI + NIN)) + n0;
        gemv16_item(F, sc, red, W + src_col(type, n0 + F.lane), N, nullptr, out, N);
    }
    const int gw = F.vcu * NWAVES + F.wave, NGW = F.G * NWAVES;
    bf16* H = (bf16*)(a.ws + WS_H); float* SS = (float*)(a.ws + WS_SS); const float* g = a.in[8]; bf16* XB = (bf16*)(a.ws + WS_XB);
    constexpr int R = 4;
    for (int row0 = gw * R; row0 < MT; row0 += NGW * R) {
        f32x4 v[R][4];
#pragma unroll
        for (int r = 0; r < R; ++r) { const int row = row0 + r; const float* xr = (row < MP) ? a.in[0] + (size_t)row * D : a.in[1] + (size_t)(row - MP) * D;
            const GAS f32x4* x4 = (const GAS f32x4*)xr + F.lane;
#pragma unroll
            for (int j = 0; j < 4; ++j) v[r][j] = x4[64 * j]; }
#pragma unroll
        for (int r = 0; r < R; ++r) {
            const int row = row0 + r; const int bb = (row < MP) ? (row >> 13) : 8 + ((row - MP) >> 5);
            float s = 0.f;
#pragma unroll
            for (int j = 0; j < 4; ++j) s += (v[r][j].x * v[r][j].x + v[r][j].y * v[r][j].y) + (v[r][j].z * v[r][j].z + v[r][j].w * v[r][j].w);
            s = wave_sum(s);
            if (F.lane == 0) ((float*)(a.ws + WS_RS))[row] = __builtin_amdgcn_rsqf(s * (1.0f / D) + EPS);
            const float* scv = mod + (size_t)bb * MODW + D;
            GAS u32x2* o8 = (GAS u32x2*)(H + (size_t)row * D) + F.lane; GAS u32x2* x8 = (GAS u32x2*)(XB + (size_t)row * D) + F.lane;
#pragma unroll
            for (int j = 0; j < 4; ++j) {
                const int c = 4 * F.lane + 256 * j;
                { u32x2 xo; xo.x = cvtpk(v[r][j].x, v[r][j].y); xo.y = cvtpk(v[r][j].z, v[r][j].w); x8[64 * j] = xo; }
                const f32x4 gv = *(const f32x4*)(g + c), sv = *(const f32x4*)(scv + c);
                const f32x4 y = v[r][j] * (gv * (sv + 1.0f));
                u32x2 o; o.x = cvtpk(y.x, y.y); o.y = cvtpk(y.z, y.w); o8[64 * j] = o;
            }
        }
    }
}
__device__ __forceinline__ float row_rstd(const float* SS, int row) {
    const f32x4* p = (const f32x4*)(SS + (size_t)row * 16); const f32x4 a = p[0], b = p[1], c = p[2], d = p[3];
    const float s = ((a.x + a.y) + (a.z + a.w)) + ((b.x + b.y) + (b.z + b.w)) + ((c.x + c.y) + (c.z + c.w)) + ((d.x + d.y) + (d.z + d.w));
    return __builtin_amdgcn_rsqf(s * (1.0f / D) + EPS);
}
__device__ __forceinline__ void rs_phase(const Frame& F, const float* SS, float* RS, int nrows) {
    for (int row = F.vcu * 512 + F.tid; row < nrows; row += F.G * 512) RS[row] = row_rstd(SS, row);
}
__device__ __forceinline__ void final_norm_phase(const Frame& F, const bf16* XB, float* Y, const float* g) {
    const int gw = F.vcu * NWAVES + F.wave, NGW = F.G * NWAVES;
    constexpr int R = 4;
    f32x4 gv[4];
#pragma unroll
    for (int j = 0; j < 4; ++j) gv[j] = *(const f32x4*)(g + 4 * F.lane + 256 * j);
    for (int row0 = gw * R; row0 < MP; row0 += NGW * R) {
        u32x2 w[R][4];
#pragma unroll
        for (int r = 0; r < R; ++r) { const GAS u32x2* x8 = (const GAS u32x2*)(XB + (size_t)(row0 + r) * D) + F.lane;
#pragma unroll
            for (int j = 0; j < 4; ++j) w[r][j] = x8[64 * j]; }
#pragma unroll
        for (int r = 0; r < R; ++r) {
            f32x4 v[4]; float s = 0.f;
#pragma unroll
            for (int j = 0; j < 4; ++j) { v[j] = (f32x4){bf_lo(w[r][j].x), bf_hi(w[r][j].x), bf_lo(w[r][j].y), bf_hi(w[r][j].y)}; s += (v[j].x * v[j].x + v[j].y * v[j].y) + (v[j].z * v[j].z + v[j].w * v[j].w); }
            const float rstd = __builtin_amdgcn_rsqf(wave_sum(s) * (1.0f / D) + EPS);
            GAS f32x4* y4 = (GAS f32x4*)(Y + (size_t)(row0 + r) * D) + F.lane;
#pragma unroll
            for (int j = 0; j < 4; ++j) y4[64 * j] = (v[j] * rstd) * gv[j];
        }
    }
}

template <class T> __device__ __forceinline__ T* uni_ptr(T* p) {
    const unsigned long long v = (unsigned long long)p; const unsigned lo = __builtin_amdgcn_readfirstlane((unsigned)v), hi = __builtin_amdgcn_readfirstlane((unsigned)(v >> 32));
    return (T*)(((unsigned long long)hi << 32) | lo);
}
using pg8::Unit;
struct EpiFFN {
    static constexpr bool PERM = true, AFTER_DRAIN = false;
    static constexpr bool HAS_TAB = true;
    ldsp lds; int ldb;
    __device__ __forceinline__ int tab_off(int par) const { return TAB_OFF + par * TAB_BYTES; }
    __device__ __forceinline__ float pre_load(const Unit& nx, int wid, int lane) const {
        if (nx.pm >= 256) return 0.f;
        const int idx = wid * 32 + (lane & 31);
        return (lane < 32) ? RS[nx.pm * 256 + idx] : bias[(size_t)(nx.pm >> 5) * ldb + nx.pn * 256 + idx];
    }
    __device__ __forceinline__ void pre_store(float v, const Unit& nx, int wid, int lane) const {
        if (nx.pm >= 256) return;
        *(LAS float*)(lds + nx.tab + (lane >= 32 ? 1024 : 0) + (wid * 32 + (lane & 31)) * 4) = v;
    }
    bf16* ACT; const float* RS; const float* bias;
    __device__ __forceinline__ void operator()(const f32x4 (&acc)[2][2][4][2], const Unit& u, int wr, int wc, int fr, int fq) const {
        asm volatile("" : "+v"(fr), "+v"(fq));
        const int lrow0 = wr * 64 + fr, col0 = u.pn * 128 + wc * 32 + 8 * fq, bc0 = u.pn * 256 + wc * 32 + 8 * fq;
        const bool smp = u.pm >= 256;
        float rs[8]; f32x4 bg0, bg1, bu0, bu1;
        if (!smp) {
#pragma unroll
            for (int it = 0; it < 8; ++it) rs[it] = *(const LAS float*)(lds + u.tab + (lrow0 + (it >> 2) * 128 + (it & 3) * 16) * 4);
            const LAS f32x4* bl = (const LAS f32x4*)(lds + u.tab + 1024 + (wc * 32 + 8 * fq) * 4);
            bg0 = bl[0]; bg1 = bl[1]; bu0 = bl[32]; bu1 = bl[33];
        } else {
#pragma unroll
            for (int it = 0; it < 8; ++it) rs[it] = RS[u.pm * 256 + lrow0 + (it >> 2) * 128 + (it & 3) * 16];
            const float* bp = bias + (size_t)8 * NFI + bc0;
            bg0 = *(const f32x4*)(bp); bg1 = *(const f32x4*)(bp + 4); bu0 = *(const f32x4*)(bp + 128); bu1 = *(const f32x4*)(bp + 132);
        }
#pragma unroll
        for (int it = 0; it < 8; ++it) {
            const int ai = it >> 2, mm = it & 3, lrow = lrow0 + ai * 128 + mm * 16;
            if (smp) { const float* bq = bias + (size_t)(8 + (lrow >> 5)) * NFI + bc0; bg0 = *(const f32x4*)(bq); bg1 = *(const f32x4*)(bq + 4); bu0 = *(const f32x4*)(bq + 128); bu1 = *(const f32x4*)(bq + 132); }
            const f32x4 g0 = acc[ai][0][mm][0] * rs[it] + bg0, g1 = acc[ai][0][mm][1] * rs[it] + bg1, u0 = acc[ai][1][mm][0] * rs[it] + bu0, u1 = acc[ai][1][mm][1] * rs[it] + bu1;
            v4u w;
            w.x = cvtpk(silu_f(g0.x) * u0.x, silu_f(g0.y) * u0.y); w.y = cvtpk(silu_f(g0.z) * u0.z, silu_f(g0.w) * u0.w);
            w.z = cvtpk(silu_f(g1.x) * u1.x, silu_f(g1.y) * u1.y); w.w = cvtpk(silu_f(g1.z) * u1.z, silu_f(g1.w) * u1.w);
            *(GAS v4u*)(ACT + (size_t)(u.pm * 256 + lrow) * DFF + col0) = w;
        }
    }
};
struct EpiRes {
    static constexpr bool PERM = true, AFTER_DRAIN = false, HAS_TAB = false;
    const bf16* xP; bf16* X; const float* gate; int halfc;
    bf16* An; const float* gnext; const float* scn; float* SS; float* PART;
    __device__ __forceinline__ void operator()(const f32x4 (&acc)[2][2][4][2], const Unit& u, int wr, int wc, int fr, int fq) const {
        asm volatile("" : "+v"(fr), "+v"(fq));
        const int col0 = u.pn * 256 + wc * 32 + 8 * fq, lrow0 = wr * 64 + fr;
        if (u.pm >= 256) {
            float* pb = PART + ((size_t)(u.kt0 >> 2) * MS + lrow0) * D + col0;
#pragma unroll
            for (int it = 0; it < 8; ++it) { float* pr = pb + (size_t)((it >> 2) * 128 + (it & 3) * 16) * D;
#pragma unroll
                for (int q = 0; q < 4; ++q) *(f32x4*)(pr + (q >> 1) * 128 + (q & 1) * 4) = acc[it >> 2][q >> 1][it & 3][q & 1]; }
            return;
        }
        const float coef = halfc ? 0.5f : 1.0f;
        const bf16* xbase = xP + (size_t)(u.pm * 256 + lrow0) * D + col0;
        constexpr int PF = 3;
        f32x4 gv[4], gs[4]; v4u xr[PF + 1][2];
        { const int bb = u.pm >> 5; const float* gp = gate + (size_t)bb * MODW + col0; const float* sp = scn + (size_t)bb * MODW + col0;
#pragma unroll
          for (int q = 0; q < 4; ++q) { const int o = (q >> 1) * 128 + (q & 1) * 4; gv[q] = *(const f32x4*)(gp + o) * coef; gs[q] = *(const f32x4*)(gnext + col0 + o) * (*(const f32x4*)(sp + o) + 1.0f); } }
#pragma unroll
        for (int p = 0; p < PF; ++p) { const bf16* xq = xbase + (size_t)((p >> 2) * 128 + (p & 3) * 16) * D; xr[p][0] = *(const GAS v4u*)(xq); xr[p][1] = *(const GAS v4u*)(xq + 128); }
#pragma unroll
        for (int it = 0; it < 8; ++it) {
            const int ai = it >> 2, mm = it & 3, lrow = lrow0 + ai * 128 + mm * 16, row = u.pm * 256 + lrow;
            if (it + PF < 8) { const bf16* xq = xbase + (size_t)(((it + PF) >> 2) * 128 + ((it + PF) & 3) * 16) * D; xr[(it + PF) % (PF + 1)][0] = *(const GAS v4u*)(xq); xr[(it + PF) % (PF + 1)][1] = *(const GAS v4u*)(xq + 128); }
            bf16* xn = X + (size_t)row * D + col0; bf16* anp = An + (size_t)row * D + col0; float ssum = 0.f;
#pragma unroll
            for (int bj = 0; bj < 2; ++bj) {
                const v4u xo = xr[it % (PF + 1)][bj];
                const f32x4 x0 = (f32x4){bf_lo(xo.x), bf_hi(xo.x), bf_lo(xo.y), bf_hi(xo.y)} + gv[2 * bj] * acc[ai][bj][mm][0], x1 = (f32x4){bf_lo(xo.z), bf_hi(xo.z), bf_lo(xo.w), bf_hi(xo.w)} + gv[2 * bj + 1] * acc[ai][bj][mm][1];
                v4u wx; wx.x = cvtpk(x0.x, x0.y); wx.y = cvtpk(x0.z, x0.w); wx.z = cvtpk(x1.x, x1.y); wx.w = cvtpk(x1.z, x1.w); *(GAS v4u*)(xn + bj * 128) = wx;
                ssum += ((x0.x * x0.x + x0.y * x0.y) + (x0.z * x0.z + x0.w * x0.w)) + ((x1.x * x1.x + x1.y * x1.y) + (x1.z * x1.z + x1.w * x1.w));
                const f32x4 y0 = x0 * gs[2 * bj], y1 = x1 * gs[2 * bj + 1];
                v4u w; w.x = cvtpk(y0.x, y0.y); w.y = cvtpk(y0.z, y0.w); w.z = cvtpk(y1.x, y1.y); w.w = cvtpk(y1.z, y1.w); *(GAS v4u*)(anp + bj * 128) = w; }
            ssum += __shfl_xor(ssum, 16); ssum += __shfl_xor(ssum, 32);
            if (fq == 0) SS[(size_t)row * 16 + u.pn * 4 + wc] = ssum;
        }
    }
};
struct ResOrder {
    pg8::StaticOrder so; int nsl, nr, nn, nks, cs;
    __device__ void init(int K, int N, int nsl_, int G_, int c_) { so.init(MP, N, G_, c_); so.ntf = K / 64; nsl = nsl_; nks = K / 64 / nsl_; nn = N / 256; nr = (so.nwg + G_ - 1) / G_; cs = c_; }
    __device__ bool next(int i, Unit& u) const {
        if (i < nr) { if (so.next(i, u)) return true; }
        const int j = (i - nr) * so.G + cs; if (i < nr || j >= nn * nsl) return false;
        u.pm = 256; u.pn = j % nn; u.kt0 = (j / nn) * nks; u.nkt = nks; return true;
    }
    __device__ __forceinline__ void a_ready(const Unit&) const {}
    __device__ __forceinline__ void done(const Unit&) const {}
};
struct CombArgs { const float* PART; int nsl; const bf16* xoldS; bf16* XS; const float* gate; float coef; bf16* AnS; const float* gnext; const float* scn; float* RSs; };
__device__ __forceinline__ void sample_combine_row(const Frame& F, const CombArgs& C, int lr, f32x4 (&xw)[4], float& rstd) {
    const int bb = 8 + (lr >> 5); float ss = 0.f;
#pragma unroll
    for (int j = 0; j < 4; ++j) { const int c = 4 * F.lane + 256 * j;
        f32x4 pp[11];
#pragma unroll
        for (int sl = 0; sl < 11; ++sl) pp[sl] = (sl < C.nsl) ? *(const f32x4*)(C.PART + ((size_t)sl * MS + lr) * D + c) : (f32x4){0.f, 0.f, 0.f, 0.f};
        f32x4 s = pp[0];
#pragma unroll
        for (int sl = 1; sl < 11; ++sl) s += pp[sl];
        const u32x2 xo = *(const GAS u32x2*)(C.xoldS + (size_t)lr * D + c);
        xw[j] = (f32x4){bf_lo(xo.x), bf_hi(xo.x), bf_lo(xo.y), bf_hi(xo.y)} + (*(const f32x4*)(C.gate + (size_t)bb * MODW + c) * C.coef) * s;
        ss += (xw[j].x * xw[j].x + xw[j].y * xw[j].y) + (xw[j].z * xw[j].z + xw[j].w * xw[j].w); }
    rstd = __builtin_amdgcn_rsqf(wave_sum(ss) * (1.0f / D) + EPS);
}
__device__ __forceinline__ void sample_combine(const Frame& F, const CombArgs& C) {
    const int gw = F.vcu * NWAVES + F.wave, NGW = F.G * NWAVES;
    for (int lr = gw; lr < MS; lr += NGW) {
        f32x4 xw[4]; float rstd; sample_combine_row(F, C, lr, xw, rstd);
        const int bb = 8 + (lr >> 5);
#pragma unroll
        for (int j = 0; j < 4; ++j) { const int c = 4 * F.lane + 256 * j;
            { u32x2 wx; wx.x = cvtpk(xw[j].x, xw[j].y); wx.y = cvtpk(xw[j].z, xw[j].w); *(GAS u32x2*)(C.XS + (size_t)lr * D + c) = wx; }
            const f32x4 y = xw[j] * (*(const f32x4*)(C.gnext + c) * (*(const f32x4*)(C.scn + (size_t)bb * MODW + c) + 1.0f));
            u32x2 w; w.x = cvtpk(y.x, y.y); w.y = cvtpk(y.z, y.w); *(GAS u32x2*)(C.AnS + (size_t)lr * D + c) = w; }
        if (F.lane == 0) C.RSs[lr] = rstd;
    }
}
struct EpiMix {
    static constexpr bool PERM = true, AFTER_DRAIN = false;
    static constexpr bool HAS_TAB = true;
    ldsp lds; int ldb;
    __device__ __forceinline__ int tab_off(int par) const { return TAB_OFF + par * TAB_BYTES; }
    __device__ __forceinline__ float pre_load(const Unit& nx, int wid, int lane) const {
        if (nx.pm >= 256) return 0.f;
        const int idx = wid * 32 + (lane & 31);
        return (lane < 32) ? row_rstd(SSp, nx.pm * 256 + idx) : bias[(size_t)(nx.pm >> 5) * ldb + nx.pn * 256 + idx];
    }
    __device__ __forceinline__ void pre_store(float v, const Unit& nx, int wid, int lane) const {
        if (nx.pm >= 256) return;
        *(LAS float*)(lds + nx.tab + (lane >= 32 ? 1024 : 0) + (wid * 32 + (lane & 31)) * 4) = v;
    }
    bf16* base6; const float* rcos; const float* rsin; float* scP; float* scS; const float* RS; const float* bias; const float* SSp;
    __device__ __forceinline__ void operator()(const f32x4 (&acc)[2][2][4][2], const Unit& u, int wr, int wc, int fr, int fq) const {
        asm volatile("" : "+v"(fr), "+v"(fq));
        const int pn = u.pn, t0 = wc * 32 + 8 * fq;
        const bool smp = u.pm >= 256;
        float rsv[8]; f32x4 B00, B01, B10, B11;
        if (!smp) {
#pragma unroll
            for (int it = 0; it < 8; ++it) rsv[it] = *(const LAS float*)(lds + u.tab + (wr * 64 + fr + (it >> 2) * 128 + (it & 3) * 16) * 4);
            const LAS f32x4* bl = (const LAS f32x4*)(lds + u.tab + 1024 + t0 * 4);
            B00 = bl[0]; B01 = bl[1]; B10 = bl[32]; B11 = bl[33];
        } else {
#pragma unroll
            for (int it = 0; it < 8; ++it) rsv[it] = RS[u.pm * 256 + wr * 64 + fr + (it >> 2) * 128 + (it & 3) * 16];
            const float* bp0 = bias + (size_t)8 * NIN + pn * 256 + t0;
            B00 = *(const f32x4*)(bp0); B01 = *(const f32x4*)(bp0 + 4); B10 = *(const f32x4*)(bp0 + 128); B11 = *(const f32x4*)(bp0 + 132);
        }
#pragma unroll
        for (int ai = 0; ai < 2; ++ai)
#pragma unroll
            for (int m = 0; m < 4; ++m) {
                const int lrow = ai * 128 + wr * 64 + m * 16 + fr, row = u.pm * 256 + lrow;
                const int pos = (u.pm < 256) ? (row & (SEQ - 1)) : PAST + (lrow & 31);
                if (smp) { const float* bp = bias + (size_t)(8 + (lrow >> 5)) * NIN + pn * 256 + t0; B00 = *(const f32x4*)(bp); B01 = *(const f32x4*)(bp + 4); B10 = *(const f32x4*)(bp + 128); B11 = *(const f32x4*)(bp + 132); }
                const float rs = rsv[ai * 4 + m];
                const f32x4 A00 = acc[ai][0][m][0] * rs + B00, A01 = acc[ai][0][m][1] * rs + B01, A10 = acc[ai][1][m][0] * rs + B10, A11 = acc[ai][1][m][1] * rs + B11;
                if (pn < 4) {
                    const int head = 2 * (pn & 1) + (wc >> 1), dd0 = (wc & 1) * 32 + 8 * fq;
                    const float sclk = (pn < 2) ? 1.0f : 0.08838834764831845f;
                    const f32x4 c0 = *(const f32x4*)(rcos + pos * 64 + dd0), c1 = *(const f32x4*)(rcos + pos * 64 + dd0 + 4);
                    const f32x4 s0 = *(const f32x4*)(rsin + pos * 64 + dd0), s1 = *(const f32x4*)(rsin + pos * 64 + dd0 + 4);
                    const f32x4 a0 = A00, a1 = A01, b0 = A10, b1 = A11;
                    const f32x4 o10 = (a0 * c0 - b0 * s0) * sclk, o11 = (a1 * c1 - b1 * s1) * sclk, o20 = (a0 * s0 + b0 * c0) * sclk, o21 = (a1 * s1 + b1 * c1) * sclk;
                    bf16* dst = base6 + (size_t)(pn >> 1) * (SZ_M512 / 2) + (size_t)row * RET + head * HD + dd0;
                    v4u w1, w2; w1.x = cvtpk(o10.x, o10.y); w1.y = cvtpk(o10.z, o10.w); w1.z = cvtpk(o11.x, o11.y); w1.w = cvtpk(o11.z, o11.w);
                    w2.x = cvtpk(o20.x, o20.y); w2.y = cvtpk(o20.z, o20.w); w2.z = cvtpk(o21.x, o21.y); w2.w = cvtpk(o21.z, o21.w);
                    *(GAS v4u*)dst = w1; *(GAS v4u*)(dst + 64) = w2;
                } else if (pn < 8 || pn >= 12) {
                    const int bi = (pn < 8) ? (pn >> 1) : 4;
                    bf16* dst = base6 + (size_t)bi * (SZ_M512 / 2) + (size_t)row * 512 + (pn & 1) * 256 + t0;
#pragma unroll
                    for (int bj = 0; bj < 2; ++bj) { const f32x4 a0 = bj ? A10 : A00, a1 = bj ? A11 : A01;
                        v4u w; w.x = cvtpk(a0.x, a0.y); w.y = cvtpk(a0.z, a0.w); w.z = cvtpk(a1.x, a1.y); w.w = cvtpk(a1.z, a1.w);
                        *(GAS v4u*)(dst + bj * 128) = w; }
                } else {
                    const int ch0 = (pn - 8) * 128 + t0;
                    const f32x4 p0 = A00 * A10, p1 = A01 * A11;
                    v4u w; w.x = cvtpk(p0.x, p0.y); w.y = cvtpk(p0.z, p0.w); w.z = cvtpk(p1.x, p1.y); w.w = cvtpk(p1.z, p1.w);
                    *(GAS v4u*)(base6 + (size_t)5 * (SZ_M512 / 2) + (size_t)row * 512 + ch0) = w;
                    if (u.pm < 256) { if (pos >= SEQ - 2) { float* d = scP + ((size_t)(row >> 13) * 2 + (pos - (SEQ - 2))) * CONVD + ch0; *(f32x4*)d = p0; *(f32x4*)(d + 4) = p1; } }
                    else { const int lp = lrow & 31; if (lp >= DSEQ - 2) { float* d = scS + ((size_t)(lrow >> 5) * 2 + (lp - (DSEQ - 2))) * CONVD + ch0; *(f32x4*)d = p0; *(f32x4*)(d + 4) = p1; } }
                }
                asm volatile("" ::: "memory");
            }
    }
};

struct RetArgs { const bf16 *Q, *K, *V, *Gt; bf16* MIX; float* T; const float* gn; const float* Sin; float* SoutP; float* SoutS; };
constexpr int RL_Q = 0, RL_K = 17408, RL_KD = 34816, RL_V = 52224, RL_P = 69632, RL_ST = 78848;
__device__ __forceinline__ s16x4 tr_read(ldsp p) { typedef short v4i16_t __attribute__((ext_vector_type(4))); return __builtin_bit_cast(s16x4, __builtin_amdgcn_ds_read_tr16_b64_v4i16((LAS v4i16_t*)p)); }
__device__ __forceinline__ bf16x8 cat4(s16x4 lo, s16x4 hi) { bf16x8 r; r[0] = lo[0]; r[1] = lo[1]; r[2] = lo[2]; r[3] = lo[3]; r[4] = hi[0]; r[5] = hi[1]; r[6] = hi[2]; r[7] = hi[3]; return r; }
__device__ __forceinline__ v4u scale8(v4u k, float s) {
    v4u r; r.x = cvtpk(bf_lo(k.x) * s, bf_hi(k.x) * s); r.y = cvtpk(bf_lo(k.y) * s, bf_hi(k.y) * s); r.z = cvtpk(bf_lo(k.z) * s, bf_hi(k.z) * s); r.w = cvtpk(bf_lo(k.w) * s, bf_hi(k.w) * s); return r; }

template <int L, bool FULL>
__device__ __forceinline__ void ret_item(const Frame& F, const RetArgs& R, int row0, int h, int nch, f32x4 (&S)[8], float lg2) {
    constexpr int NB = L / 16, KS = L / 32, NLD = L / 32;
    const int wave = F.wave, lr = F.tid >> 4, c16 = F.tid & 15;
    const ldsp lds = F.lds;
    v4u rq[NLD], rk[NLD], rv[NLD];
#define RET_GLOAD(ch) do { _Pragma("unroll") for (int i = 0; i < NLD; ++i) { const size_t off = (size_t)(row0 + (ch) * L + lr + 32 * i) * RET + h * HD + c16 * 8; \
        if (FULL) rq[i] = *(const GAS v4u*)(R.Q + off); rk[i] = *(const GAS v4u*)(R.K + off); rv[i] = *(const GAS v4u*)(R.V + off); } } while (0)
    RET_GLOAD(0);
    const float gL = fexp2(lg2 * (float)L);
    for (int ch = 0; ch < nch; ++ch) {
        int lane = F.lane; asm volatile("" : "+v"(lane));
        const int fr = lane & 15, fq = lane >> 4;
        const int b272 = fr * 272 + fq * 16, bq8 = fr * 272 + fq * 8, btr = (fq * 8 + (fr >> 2)) * 272 + (fr & 3) * 8, b144w = fr * 144 + fq * 8, b144r = fr * 144 + fq * 16, bst = fr * 64;
        const int okd = FULL ? RL_KD : ((ch & 1) ? RL_Q : RL_KD), ov = FULL ? RL_V : ((ch & 1) ? RL_K : RL_V);
        {   int tl = F.tid; asm volatile("" : "+v"(tl)); const int ow = (tl >> 4) * 272 + (tl & 15) * 16;
#pragma unroll
            for (int i = 0; i < NLD; ++i) { const int j = (tl >> 4) + 32 * i; const int o = ow + i * 32 * 272;
                if (FULL) { *(LAS v4u*)(lds + RL_Q + o) = rq[i]; *(LAS v4u*)(lds + RL_K + o) = rk[i]; }
                *(LAS v4u*)(lds + okd + o) = scale8(rk[i], fexp2(lg2 * (float)(L - 1 - j)));
                *(LAS v4u*)(lds + ov + o) = rv[i]; } }
        LDS_WAIT(); __syncthreads();
        if (ch + 1 < nch) RET_GLOAD(ch + 1);
        f32x4 o[NB];
        bf16x8 vf[KS];
        u32x2 gpre[NB];
        if (FULL) {
#pragma unroll
            for (int ib = 0; ib < NB; ++ib) gpre[ib] = *(const GAS u32x2*)(R.Gt + (size_t)(row0 + ch * L + ib * 16 + fr) * RET + h * HD + wave * 16 + fq * 4); }
        if (FULL) {
            for (int blk = wave; blk < NB * NB; blk += 8) {
                const int ib = blk / NB, jb = blk % NB;
                f32x4 acc = {0.f, 0.f, 0.f, 0.f};
                const ldsp kp = lds + RL_K + jb * (16 * 272) + b272, qp = lds + RL_Q + ib * (16 * 272) + b272;
#pragma unroll
                for (int s = 0; s < 4; ++s) {
                    const bf16x8 ka = *(const LAS bf16x8*)(kp + s * 64);
                    const bf16x8 qb = *(const LAS bf16x8*)(qp + s * 64);
                    acc = __builtin_amdgcn_mfma_f32_16x16x32_bf16(ka, qb, acc, 0, 0, 0);
                }
                const int dij = (ib - jb) * 16 + fr - fq * 4;
                float p[4];
#pragma unroll
                for (int t = 0; t < 4; ++t) { const int dj = dij - t; p[t] = acc[t] * fexp2(lg2 * (float)(dj < 0 ? -dj : dj)); }
                u32x2 w; w.x = cvtpk(p[0], p[1]); w.y = cvtpk(p[2], p[3]);
                *(LAS u32x2*)(lds + RL_P + ib * (16 * 144) + jb * 32 + b144w) = w;
            }
            LDS_WAIT(); __syncthreads();
        }
        __builtin_amdgcn_sched_barrier(0);
        {   const ldsp p = lds + ov + wave * 32 + btr;
#pragma unroll
            for (int ks = 0; ks < KS; ++ks) vf[ks] = cat4(tr_read(p + ks * (32 * 272)), tr_read(p + ks * (32 * 272) + 4 * 272)); }
        if (FULL) {
            __builtin_amdgcn_sched_barrier(0);
            bf16x8 sf[4];
#pragma unroll
            for (int s = 0; s < 4; ++s) { v4u w; w.x = cvtpk(S[2 * s][0], S[2 * s][1]); w.y = cvtpk(S[2 * s][2], S[2 * s][3]); w.z = cvtpk(S[2 * s + 1][0], S[2 * s + 1][1]); w.w = cvtpk(S[2 * s + 1][2], S[2 * s + 1][3]);
                sf[s] = __builtin_bit_cast(bf16x8, w); }
            const float cdl = lg2 * (float)(fr + 1);
#pragma unroll
            for (int ib = 0; ib < NB; ++ib) {
                f32x4 acc = {0.f, 0.f, 0.f, 0.f};
                const ldsp qrow = lds + RL_Q + ib * (16 * 272) + bq8;
#pragma unroll
                for (int s = 0; s < 4; ++s) {
                    const u32x2 lo = *(const LAS u32x2*)(qrow + (2 * s) * 32), hi = *(const LAS u32x2*)(qrow + (2 * s + 1) * 32);
                    v4u w; w.x = lo.x; w.y = lo.y; w.z = hi.x; w.w = hi.y;
                    acc = __builtin_amdgcn_mfma_f32_16x16x32_bf16(sf[s], __builtin_bit_cast(bf16x8, w), acc, 0, 0, 0);
                }
                acc = acc * fexp2(cdl + lg2 * (float)(ib * 16));
                const ldsp pp = lds + RL_P + ib * (16 * 144) + b144r;
#pragma unroll
                for (int ks = 0; ks < KS; ++ks) {
                    const bf16x8 pb = *(const LAS bf16x8*)(pp + ks * 64);
                    acc = __builtin_amdgcn_mfma_f32_16x16x32_bf16(vf[ks], pb, acc, 0, 0, 0);
                }
                o[ib] = acc;
                asm volatile("" ::: "memory");
            }
        }
        __builtin_amdgcn_sched_barrier(0);
        {   const ldsp kd = lds + okd + btr;
#pragma unroll
            for (int db = 0; db < 8; ++db) {
                f32x4 acc = S[db] * gL;
#pragma unroll
                for (int ks = 0; ks < KS; ++ks) { const ldsp p = kd + db * 32 + ks * (32 * 272);
                    acc = __builtin_amdgcn_mfma_f32_16x16x32_bf16(cat4(tr_read(p), tr_read(p + 4 * 272)), vf[ks], acc, 0, 0, 0); }
                S[db] = acc;
                if (db & 1) asm volatile("" ::: "memory");
            } }
        __builtin_amdgcn_sched_barrier(0);
        if (FULL) {
#pragma unroll
            for (int ib = 0; ib < NB; ++ib) {
                float s1 = (o[ib][0] + o[ib][1]) + (o[ib][2] + o[ib][3]);
                float s2 = (o[ib][0] * o[ib][0] + o[ib][1] * o[ib][1]) + (o[ib][2] * o[ib][2] + o[ib][3] * o[ib][3]);
                s1 += __shfl_xor(s1, 16); s1 += __shfl_xor(s1, 32); s2 += __shfl_xor(s2, 16); s2 += __shfl_xor(s2, 32);
                if (fq == 0) { f32x2s w; w.x = s1; w.y = s2; *(LAS f32x2s*)(lds + RL_ST + ib * 1024 + wave * 8 + bst) = w; }
            }
            LDS_WAIT(); __syncthreads();
            const int e0 = wave * 16 + fq * 4;
            const f32x4 gnv = *(const f32x4*)(R.gn + h * HD + e0);
#pragma unroll
            for (int ib = 0; ib < NB; ++ib) {
                float s1 = 0.f, s2 = 0.f;
#pragma unroll
                for (int w8 = 0; w8 < 8; ++w8) { const f32x2s w = *(const LAS f32x2s*)(lds + RL_ST + ib * 1024 + w8 * 8 + bst); s1 += w.x; s2 += w.y; }
                const float mu = s1 * (1.0f / HD); float var = s2 * (1.0f / HD) - mu * mu; var = var < 0.f ? 0.f : var;
                const float rstd = __builtin_amdgcn_rsqf(var + EPS);
                const size_t row = (size_t)(row0 + ch * L + ib * 16 + fr);
                const u32x2 gw = gpre[ib];
                const float y0 = silu_f(bf_lo(gw.x)) * ((o[ib][0] - mu) * rstd * gnv.x), y1 = silu_f(bf_hi(gw.x)) * ((o[ib][1] - mu) * rstd * gnv.y);
                const float y2 = silu_f(bf_lo(gw.y)) * ((o[ib][2] - mu) * rstd * gnv.z), y3 = silu_f(bf_hi(gw.y)) * ((o[ib][3] - mu) * rstd * gnv.w);
                u32x2 w; w.x = cvtpk(y0, y1); w.y = cvtpk(y2, y3);
                *(GAS u32x2*)(R.MIX + row * D + h * HD + e0) = w;
                asm volatile("" ::: "memory");
            }
        }
    }
#undef RET_GLOAD
}

__device__ __forceinline__ float lg2_of_head(int h) { return h == 0 ? -0.04580368961312479f : h == 1 ? -0.02272007650008353f : h == 2 ? -0.011315313227834146f : -0.005646563141142063f; }

__device__ __forceinline__ void ret_phase_a(const Frame& F, const RetArgs& R) {
    for (int v = F.vcu; v < 256; v += F.G) {
        const int bh = v >> 3, s = v & 7, b = bh >> 2, h = bh & 3; const float lg2 = lg2_of_head(h);
        for (int half = 0; half < 2; ++half) {
            const int sc = half ? 15 - s : s; if (sc == 15) continue;
            f32x4 S[8];
#pragma unroll
            for (int db = 0; db < 8; ++db) S[db] = (f32x4){0.f, 0.f, 0.f, 0.f};
            ret_item<64, false>(F, R, b * SEQ + sc * 512, h, 8, S, lg2);
            float* T = R.T + (size_t)(bh * 16 + sc) * 16384;
#pragma unroll
            for (int db = 0; db < 8; ++db) *(GAS f32x4*)(T + ((F.wave * 8 + db) * 64 + F.lane) * 4) = S[db];
        }
    }
}
#define LAUNDER_FRFQ() int ln_ = F.lane; asm volatile("" : "+v"(ln_)); const int fr = ln_ & 15, fq = ln_ >> 4
__device__ __forceinline__ void ret_phase_c(const Frame& F, const RetArgs& R) {
    for (int v = F.vcu; v < 256; v += F.G) {
        const int bh = v >> 3, s = v & 7, b = bh >> 2, h = bh & 3; const float lg2 = lg2_of_head(h); const float g512 = fexp2(lg2 * 512.f);
        for (int half = 0; half < 2; ++half) {
            const int sc = half ? 15 - s : s;
            f32x4 S[8];
#pragma unroll
            for (int db = 0; db < 8; ++db) S[db] = (f32x4){0.f, 0.f, 0.f, 0.f};
            {   const float* Tl = R.T + (size_t)(bh * 16) * 16384 + (size_t)(F.wave * 8 * 64 + F.lane) * 4;
                int p = 0;
                for (; p + 4 <= sc; p += 4) {
                    f32x4 t0[8], t1[8], t2[8], t3[8];
#pragma unroll
                    for (int db = 0; db < 8; ++db) { t0[db] = *(const GAS f32x4*)(Tl + (size_t)p * 16384 + db * 256); t1[db] = *(const GAS f32x4*)(Tl + (size_t)(p + 1) * 16384 + db * 256);
                        t2[db] = *(const GAS f32x4*)(Tl + (size_t)(p + 2) * 16384 + db * 256); t3[db] = *(const GAS f32x4*)(Tl + (size_t)(p + 3) * 16384 + db * 256); }
#pragma unroll
                    for (int db = 0; db < 8; ++db) S[db] = (((S[db] * g512 + t0[db]) * g512 + t1[db]) * g512 + t2[db]) * g512 + t3[db];
                }
                for (; p < sc; ++p) {
#pragma unroll
                    for (int db = 0; db < 8; ++db) S[db] = S[db] * g512 + *(const GAS f32x4*)(Tl + (size_t)p * 16384 + db * 256); }
            }
            ret_item<64, true>(F, R, b * SEQ + sc * 512, h, 8, S, lg2);
            if (sc == 15) { LAUNDER_FRFQ(); float* So = R.SoutP + (size_t)bh * 16384;
#pragma unroll
                for (int db = 0; db < 8; ++db)
#pragma unroll
                    for (int t = 0; t < 4; ++t) So[(db * 16 + fq * 4 + t) * HD + F.wave * 16 + fr] = S[db][t]; }
        }
        if (v < 32) {
            const float* Si = R.Sin + (size_t)v * 16384; f32x4 S[8];
            { LAUNDER_FRFQ();
#pragma unroll
            for (int db = 0; db < 8; ++db)
#pragma unroll
                for (int t = 0; t < 4; ++t) S[db][t] = Si[(db * 16 + fq * 4 + t) * HD + F.wave * 16 + fr]; }
            ret_item<32, true>(F, R, MP + (v >> 2) * DSEQ, v & 3, 1, S, lg2_of_head(v & 3));
            LAUNDER_FRFQ(); float* So = R.SoutS + (size_t)v * 16384;
#pragma unroll
            for (int db = 0; db < 8; ++db)
#pragma unroll
                for (int t = 0; t < 4; ++t) So[(db * 16 + fq * 4 + t) * HD + F.wave * 16 + fr] = S[db][t];
        }
    }
}
__device__ __forceinline__ void conv_prompt(const Frame& F, const bf16* U, const bf16* BG, const float* cw, const float* cb, bf16* MIX, int worker, int nworkers) {
    for (int it = worker * 512 + F.tid; it < (MP / 8) * 64; it += nworkers * 512) {
        const int c8 = (it & 63) * 8, row0 = (it >> 6) * 8; const bool first = (row0 & (SEQ - 1)) == 0;
        v4u uw[10], bw[8];
        const GAS v4u* up = (const GAS v4u*)(U + (size_t)row0 * 512 + c8); const GAS v4u* bp = (const GAS v4u*)(BG + (size_t)row0 * 512 + c8);
        uw[0] = first ? (v4u){0u, 0u, 0u, 0u} : up[-128]; uw[1] = first ? (v4u){0u, 0u, 0u, 0u} : up[-64];
#pragma unroll
        for (int r = 0; r < 8; ++r) { uw[2 + r] = up[64 * r]; bw[r] = bp[64 * r]; }
        const f32x4 w0a = *(const f32x4*)(cw + c8), w0b = *(const f32x4*)(cw + c8 + 4), w1a = *(const f32x4*)(cw + CONVD + c8), w1b = *(const f32x4*)(cw + CONVD + c8 + 4);
        const f32x4 w2a = *(const f32x4*)(cw + 2 * CONVD + c8), w2b = *(const f32x4*)(cw + 2 * CONVD + c8 + 4), cba = *(const f32x4*)(cb + c8), cbb = *(const f32x4*)(cb + c8 + 4);
#define CP_LO(v_) ((f32x4){bf_lo((v_).x), bf_hi((v_).x), bf_lo((v_).y), bf_hi((v_).y)})
#define CP_HI(v_) ((f32x4){bf_lo((v_).z), bf_hi((v_).z), bf_lo((v_).w), bf_hi((v_).w)})
#pragma unroll
        for (int r = 0; r < 8; ++r) {
            const f32x4 ya = CP_LO(bw[r]) * (cba + w0a * CP_LO(uw[r]) + w1a * CP_LO(uw[r + 1]) + w2a * CP_LO(uw[r + 2]));
            const f32x4 yb = CP_HI(bw[r]) * (cbb + w0b * CP_HI(uw[r]) + w1b * CP_HI(uw[r + 1]) + w2b * CP_HI(uw[r + 2]));
            v4u w; w.x = cvtpk(ya.x, ya.y); w.y = cvtpk(ya.z, ya.w); w.z = cvtpk(yb.x, yb.y); w.w = cvtpk(yb.z, yb.w);
            *(GAS v4u*)(MIX + (size_t)(row0 + r) * D + 512 + c8) = w;
        }
#undef CP_LO
#undef CP_HI
    }
}
__device__ __forceinline__ void conv_phase(const Frame& F, const bf16* U, const bf16* BG, const float* cw, const float* cb, const float* hist, bf16* MIX, int idx0, int idx1, int worker, int nworkers) {
    for (int idx = idx0 + worker * 512 + F.tid; idx < idx1; idx += nworkers * 512) {
        const int row = idx >> 6, c8 = (idx & 63) * 8;
        int pos, bs = 0; if (row < MP) pos = row & (SEQ - 1); else { pos = (row - MP) & 31; bs = (row - MP) >> 5; }
        const bool smp = row >= MP;
        float u0[8], u1[8], u2[8], bg[8];
        { const v4u w = *(const GAS v4u*)(U + (size_t)row * 512 + c8); u0[0] = bf_lo(w.x); u0[1] = bf_hi(w.x); u0[2] = bf_lo(w.y); u0[3] = bf_hi(w.y); u0[4] = bf_lo(w.z); u0[5] = bf_hi(w.z); u0[6] = bf_lo(w.w); u0[7] = bf_hi(w.w); }
        { const v4u w = *(const GAS v4u*)(BG + (size_t)row * 512 + c8); bg[0] = bf_lo(w.x); bg[1] = bf_hi(w.x); bg[2] = bf_lo(w.y); bg[3] = bf_hi(w.y); bg[4] = bf_lo(w.z); bg[5] = bf_hi(w.z); bg[6] = bf_lo(w.w); bg[7] = bf_hi(w.w); }
        if (pos >= 1) { const v4u w = *(const GAS v4u*)(U + (size_t)(row - 1) * 512 + c8); u1[0] = bf_lo(w.x); u1[1] = bf_hi(w.x); u1[2] = bf_lo(w.y); u1[3] = bf_hi(w.y); u1[4] = bf_lo(w.z); u1[5] = bf_hi(w.z); u1[6] = bf_lo(w.w); u1[7] = bf_hi(w.w); }
        else {
#pragma unroll
            for (int q = 0; q < 8; ++q) u1[q] = smp ? hist[((size_t)bs * 2 + 1) * CONVD + c8 + q] : 0.f; }
        if (pos >= 2) { const v4u w = *(const GAS v4u*)(U + (size_t)(row - 2) * 512 + c8); u2[0] = bf_lo(w.x); u2[1] = bf_hi(w.x); u2[2] = bf_lo(w.y); u2[3] = bf_hi(w.y); u2[4] = bf_lo(w.z); u2[5] = bf_hi(w.z); u2[6] = bf_lo(w.w); u2[7] = bf_hi(w.w); }
        else {
#pragma unroll
            for (int q = 0; q < 8; ++q) u2[q] = smp ? hist[((size_t)bs * 2 + pos) * CONVD + c8 + q] : 0.f; }
        float y[8];
#pragma unroll
        for (int q = 0; q < 8; ++q) { const int c = c8 + q; y[q] = bg[q] * (cb[c] + cw[c] * u2[q] + cw[CONVD + c] * u1[q] + cw[2 * CONVD + c] * u0[q]); }
        v4u w; w.x = cvtpk(y[0], y[1]); w.y = cvtpk(y[2], y[3]); w.z = cvtpk(y[4], y[5]); w.w = cvtpk(y[6], y[7]);
        *(GAS v4u*)(MIX + (size_t)row * D + 512 + c8) = w;
    }
}

constexpr int NPHASE = 25;
#define MK_RETARGS() RetArgs R{Qb, Kb, Vb, Gb, MIXb, (float*)(ws + WS_T), a.in[13] + l * RET, a.in[4] + (size_t)l * 8 * NHEAD * HD * HD, a.out + OFF_SRP + (size_t)l * 8 * NHEAD * HD * HD, a.out + OFF_SRS + (size_t)l * 8 * NHEAD * HD * HD}
#ifndef PG8_SP2
#define PG8_SP2 true
#endif
#ifndef PG8_ALIGN
#define PG8_ALIGN true
#endif

__global__ void __launch_bounds__(NWAVES * 64, 2) fwd_kernel(Args a) {
    extern __shared__ __attribute__((aligned(16))) unsigned char lds_raw[];
    Frame F;
    F.lds = (ldsp)lds_raw; F.tid = threadIdx.x; F.lane = F.tid & 63; F.wave = __builtin_amdgcn_readfirstlane(F.tid >> 6);
    F.G = gridDim.x; { const int bx = blockIdx.x; F.vcu = (F.G % 8 == 0) ? (bx % 8) * (F.G / 8) + bx / 8 : bx; }
    volatile LAS unsigned* MISC = (volatile LAS unsigned*)(F.lds + MISC_OFF);
    for (int u = F.tid; u < (LDS_BYTES - LDSCTL_OFF) / 4; u += NWAVES * 64) ((LAS unsigned*)(F.lds + LDSCTL_OFF))[u] = 0u;
    __syncthreads();
    const bool multi = (a.ph_hi - a.ph_lo) > 1;
    XcdBarrier bar; bar.bar = (unsigned*)(a.ws + WS_CTL) + CW_BAR; bar.x = 0; bar.st = nullptr;
    if (multi) bar = xcd_barrier_post((unsigned*)(a.ws + WS_CTL) + CW_BAR, MISC + 8);

    unsigned char* ws = a.ws;
    bf16* X = (bf16*)(ws + WS_XB);
    bf16* H = (bf16*)(ws + WS_H);
    bf16* ACT = (bf16*)(ws + WS_BIG);
    bf16* Qb = (bf16*)(ws + WS_BIG); bf16* Kb = (bf16*)(ws + WS_BIG + SZ_M512); bf16* Vb = (bf16*)(ws + WS_BIG + 2 * SZ_M512);
    bf16* Gb = (bf16*)(ws + WS_BIG + 3 * SZ_M512); bf16* BGb = (bf16*)(ws + WS_BIG + 4 * SZ_M512); bf16* Ub = (bf16*)(ws + WS_BIG + 5 * SZ_M512);
    const float* rcos = (const float*)(ws + WS_ROPE); const float* rsin = rcos + 8192 * 64;

    const Frame F0 = F;
    for (int ph = a.ph_lo; ph < a.ph_hi; ++ph) {
        if (ph == 2 || ph == 5 || ph == 16) continue;
        { int t_ = F0.tid; asm volatile("" : "+v"(t_)); F.tid = t_; F.lane = t_ & 63; F.wave = __builtin_amdgcn_readfirstlane(t_ >> 6); }
        if (ph == 0) { p0_prologue(F, a); }
        else if (ph == NPHASE - 1) {
            final_norm_phase(F, X, a.out, a.in[20]);
            const float* modp = (const float*)(ws + WS_MOD) + (size_t)(DEPTH - 1) * 16 * MODW;
            CombArgs C{(const float*)(ws + WS_PART), 11, X + (size_t)MP * D, X + (size_t)MP * D, modp + (size_t)8 * D, 0.5f, nullptr, nullptr, nullptr, nullptr};
            const int gw = F.vcu * NWAVES + F.wave, NGW = F.G * NWAVES;
            for (int lr = gw; lr < MS; lr += NGW) { f32x4 xw[4]; float rstd; sample_combine_row(F, C, lr, xw, rstd);
#pragma unroll
                for (int j = 0; j < 4; ++j) { const int c = 4 * F.lane + 256 * j; *(f32x4*)(a.out + (size_t)(MP + lr) * D + c) = (xw[j] * rstd) * *(const f32x4*)(a.in[20] + c); } }
        }
        else if (ph == 1) { prepass_phase(F, a); }
        else {
            const int l = (ph - 2) / 11, kk = (ph - 2) % 11;
            const int k = (kk == 0 || kk == 3 || kk == 8) ? -1 : (kk < 3 ? kk - 1 : kk < 8 ? kk - 2 : kk - 3);
            const float* mod = (const float*)(ws + WS_MOD); const float* modl = mod + (size_t)l * 16 * MODW;
            const unsigned char* wl = ws + WS_W + (size_t)l * W_LAYER;
            const float* SS = (const float*)(ws + WS_SS); float* RS = (float*)(ws + WS_RS); const float* biasl = (const float*)(ws + WS_BIAS) + (size_t)l * BIAS_LAYER;
            bf16* MIXb = (bf16*)(ws + WS_MIX);
            if (k < 0) {
                if (kk == 0 && l == 0) rs_phase(F, SS, RS, MT);
                else {
                    const int lp = (kk == 0) ? l - 1 : l;
                    const float* modp = mod + (size_t)lp * 16 * MODW;
                    const float* gnx = (kk == 3) ? a.in[11] + l * D : (kk == 8) ? a.in[17] + l * D : a.in[8] + l * D;
                    CombArgs C{(const float*)(ws + WS_PART), (kk == 8) ? 4 : 11, X + (size_t)MP * D, X + (size_t)MP * D,
                               modp + (size_t)(kk == 3 ? 2 : kk == 8 ? 5 : 8) * D, (kk == 8) ? 1.0f : 0.5f, H + (size_t)MP * D, gnx, mod + (size_t)l * 16 * MODW + (size_t)(kk == 3 ? 4 : kk == 8 ? 7 : 1) * D, RS + MP};
                    sample_combine(F, C);
                    rs_phase(F, SS, RS, MP);
                }
            }
            else if (k == 0 || k == 6) {
                pg8::Gemm g{H, (const bf16*)(wl + (k == 0 ? W_1I : W_2I)), MT, NFI, D}; ResOrder S; S.init(D, NFI, 1, F.G, (int)blockIdx.x);
                EpiFFN E{F.lds, NFI, ACT, RS, biasl + (k == 0 ? 0 : (size_t)16 * (NFI + NIN))};
                pg8::gemm_phase<EpiFFN, ResOrder, PG8_ALIGN, PG8_SP2>(F.lds, g, S, E);
            } else if (k == 1 || k == 5 || k == 7) {
                pg8::Gemm g{k == 5 ? MIXb : ACT, (const bf16*)(wl + (k == 1 ? W_1O : k == 5 ? W_OUT : W_2O)), MT, D, k == 5 ? D : DFF};
                ResOrder S; S.init(k == 5 ? D : DFF, D, (k == 5 ? D : DFF) / 256, F.G, (int)blockIdx.x);
                const int ln = (k == 7 && l + 1 < DEPTH) ? l + 1 : l;
                const float* gnext = (k == 1) ? a.in[11] + l * D : (k == 5) ? a.in[17] + l * D : (l + 1 < DEPTH ? a.in[8] + ln * D : a.in[20]);
                const float* scn = mod + (size_t)ln * 16 * MODW + (size_t)(k == 1 ? 4 : k == 5 ? 7 : 1) * D;
                EpiRes E{X, X, uni_ptr(modl + (k == 1 ? 2 : k == 5 ? 5 : 8) * D), __builtin_amdgcn_readfirstlane(k == 5 ? 0 : 1), H, uni_ptr(gnext), uni_ptr(scn), (float*)(ws + WS_SS), (float*)(ws + WS_PART)};
                pg8::gemm_phase<EpiRes, ResOrder, PG8_ALIGN, PG8_SP2>(F.lds, g, S, E);
            } else if (k == 2 || k == 3) {
                constexpr int NSU = NIN / 256; const int nsu = (F.G > 2 * NSU) ? NSU : 0;
                pg8::Gemm g{H, (const bf16*)(wl + W_IN), MT, NIN, D}; ResOrder S; S.init(D, NIN, 1, F.G, (int)blockIdx.x);
                if (k == 2) { if (nsu) S.nsl = 0;
                    CombArgs C{(const float*)(ws + WS_PART), 11, X + (size_t)MP * D, X + (size_t)MP * D, modl + (size_t)2 * D, 0.5f, H + (size_t)MP * D, a.in[11] + l * D, modl + (size_t)4 * D, RS + MP};
                    sample_combine(F, C);
                } else { S.nr = 0; S.cs = F.vcu; if (!nsu) S.nsl = 0; }
                EpiMix E{F.lds, NIN, Qb, rcos, rsin, a.out + OFF_SCP + (size_t)l * 8 * 2 * CONVD, a.out + OFF_SCS + (size_t)l * 8 * 2 * CONVD, RS, biasl + (size_t)16 * NFI, SS};
                pg8::gemm_phase<EpiMix, ResOrder, PG8_ALIGN, PG8_SP2>(F.lds, g, S, E);
                if (k == 3) {
                    __syncthreads();
                    { MK_RETARGS(); ret_phase_a(F, R); }
                    if (F.vcu >= nsu) conv_prompt(F, Ub, BGb, a.in[14] + (size_t)l * 3 * CONVD, a.in[15] + (size_t)l * CONVD, MIXb, F.vcu - nsu, F.G - nsu);
                }
            } else {
                conv_phase(F, Ub, BGb, a.in[14] + (size_t)l * 3 * CONVD, a.in[15] + (size_t)l * CONVD, a.in[5] + (size_t)l * 8 * 2 * CONVD, MIXb, MP * 64, MT * 64, F.vcu, F.G);
                { MK_RETARGS(); ret_phase_c(F, R); }
            }
        }
        if (ph + 1 < a.ph_hi) {
            if (a.ph_hi > NPHASE) { __threadfence(); cg::this_grid().sync(); }
            else xcd_barrier(bar);
        }
    }
}

#ifndef MK_SINGLE
#define MK_SINGLE 0
#endif
extern "C" void kernel_launch(void* const* d_in, const int* in_sizes, int n_in, void* d_out, int out_size, void* d_ws, size_t ws_size, hipStream_t stream) {
    static int grid = 0;
    if (grid == 0) {
        if (n_in != 21 || ws_size < WS_END) { fprintf(stderr, "kernel_launch: unexpected problem (n_in %d, ws %zu)\n", n_in, ws_size); grid = -1; return; }
        int dev = 0, cus = 0, per_cu = 0;
        if (hipGetDevice(&dev) != hipSuccess || hipDeviceGetAttribute(&cus, hipDeviceAttributeMultiprocessorCount, dev) != hipSuccess) { grid = -1; return; }
        if (hipFuncSetAttribute((const void*)fwd_kernel, hipFuncAttributeMaxDynamicSharedMemorySize, LDS_BYTES) != hipSuccess) { fprintf(stderr, "kernel_launch: hipFuncSetAttribute failed\n"); grid = -1; return; }
        if (hipOccupancyMaxActiveBlocksPerMultiprocessor(&per_cu, (const void*)fwd_kernel, NWAVES * 64, LDS_BYTES) != hipSuccess || per_cu < 1) { fprintf(stderr, "kernel_launch: occupancy query says %d\n", per_cu); per_cu = 1; }
        (void)hipGetLastError();
        grid = cus * per_cu;
    }
    if (grid < 0) return;
    (void)hipMemsetAsync((char*)d_ws + WS_CTL, 0, CTL_ZERO_BYTES, stream);
    Args a{};
    for (int i = 0; i < 21; ++i) a.in[i] = (const float*)d_in[i];
    a.out = (float*)d_out; a.ws = (unsigned char*)d_ws;
#if MK_SINGLE
    a.ph_lo = 0; a.ph_hi = NPHASE;
    void* args[] = {&a};
    hipError_t e = hipLaunchCooperativeKernel((const void*)fwd_kernel, dim3(grid), dim3(NWAVES * 64), args, LDS_BYTES, stream);
    if (e != hipSuccess) fprintf(stderr, "cooperative launch failed: %s (grid %d)\n", hipGetErrorString(e), grid);
#else
    for (int ph = 0; ph < NPHASE; ++ph) {
        a.ph_lo = ph; a.ph_hi = ph + 1;
        hipLaunchKernelGGL(fwd_kernel, dim3(grid), dim3(NWAVES * 64), LDS_BYTES, stream, a);
    }
#endif
}
```
